# Optimizing an MI355X kernel written in HIP

```python
import jax, jax.numpy as jnp
from jax import lax
import numpy as np

D_MODEL = 1024
BATCH = 32
SEQ = 256
DEPTH = 2
DEC_BATCH = 2
DEC_SEQ = 4096
PAST_LEN = 512

GRID_W = 64
H_HGRN = 4
DK_HGRN = 64
DV_HGRN = 64
HGRN_CHUNK = 32
H_MLA = 8
Q_RANK = 384
KV_RANK = 256
D_NOPE = 64
D_ROPE = 32
D_V = 64
D_QK = D_NOPE + D_ROPE
ROPE_THETA = 10000.0
Q_BLOCK = 128
G_FNET = 4
C_FNET = 64
W_HGRN = H_HGRN * DV_HGRN
W_MLA = H_MLA * D_V
W_FNET = G_FNET * C_FNET
MIX_WIDTH = W_HGRN + W_MLA + W_FNET
IN_SIZES = (H_HGRN * DK_HGRN, H_HGRN * DK_HGRN, H_HGRN * DK_HGRN, W_HGRN, W_HGRN, Q_RANK, KV_RANK, D_ROPE, W_FNET)
IN_WIDTH = sum(IN_SIZES)
D_FF = 2816
N_MOD = 9
EPS = 1e-6

kernel_name = 'hybrid_hgrn2_mla_fnet_diffusion_step'


def rmsnorm(x, g):
    xf = x.astype(jnp.float32)
    y = xf * lax.rsqrt(jnp.mean(xf * xf, axis=-1, keepdims=True) + EPS)
    return (y * g.astype(jnp.float32)).astype(x.dtype)


def swiglu(h, w_gu, w_down):
    gate, up = jnp.split(h @ w_gu, 2, axis=-1)
    return (jax.nn.silu(gate) * up) @ w_down


def axial_rope_tables(L):
    rows = L // GRID_W
    row = jnp.repeat(jnp.arange(rows, dtype=jnp.float32), GRID_W)
    col = jnp.tile(jnp.arange(GRID_W, dtype=jnp.float32), rows)
    pos = jnp.stack([row, col], axis=-1)
    n_freq = D_ROPE // 4
    freq = ROPE_THETA ** (-jnp.arange(n_freq, dtype=jnp.float32) / n_freq)
    ang = pos[:, :, None] * freq
    return jnp.cos(ang), jnp.sin(ang)


def apply_axial_rope(x, cos, sin):
    shp = x.shape
    xr = x.astype(jnp.float32).reshape(shp[:-1] + (2, 2, D_ROPE // 4))
    x1, x2 = xr[..., 0, :], xr[..., 1, :]
    out = jnp.stack([x1 * cos - x2 * sin, x2 * cos + x1 * sin], axis=-2)
    return out.reshape(shp).astype(x.dtype)


def block_attention(q, k, v):
    B, Lq, H, E = q.shape
    nb = Lq // Q_BLOCK
    scale = E ** -0.5
    qb = q.reshape(B, nb, Q_BLOCK, H, E).transpose(1, 0, 2, 3, 4)

    def attend(qi):
        s = jnp.einsum('bqhe,bkhe->bhqk', qi, k).astype(jnp.float32) * scale
        pr = jax.nn.softmax(s, axis=-1).astype(v.dtype)
        return jnp.einsum('bhqk,bkhd->bqhd', pr, v)

    o = lax.map(attend, qb)
    return o.transpose(1, 0, 2, 3, 4).reshape(B, Lq, H, v.shape[-1])


def hgrn_gates(f_raw, lb):
    x = f_raw.astype(jnp.float32)
    lbf = lb.astype(jnp.float32)
    g = jnp.logaddexp(jnp.log(lbf), jnp.log1p(-lbf) + jax.nn.log_sigmoid(x))
    return g, -jnp.expm1(g)


def hgrn_scan(q, k, v, g, s0):
    B, L, H, DK = q.shape
    DV = v.shape[-1]
    n = L // HGRN_CHUNK

    def chunks(a):
        return a.astype(jnp.float32).reshape(B, n, HGRN_CHUNK, H, a.shape[-1]).transpose(1, 0, 3, 2, 4)

    mask = jnp.tril(jnp.ones((HGRN_CHUNK, HGRN_CHUNK), dtype=bool))[:, :, None]

    def step(S, inp):
        qc, kc, vc, gc = inp
        b = jnp.cumsum(gc, axis=2)
        o_inter = jnp.einsum('bhtk,bhkv->bhtv', qc * jnp.exp(b), S)
        diff = b[:, :, :, None, :] - b[:, :, None, :, :]
        decay = jnp.exp(jnp.where(mask, diff, -jnp.inf))
        scores = jnp.einsum('bhtsk,bhsk->bhts', decay * qc[:, :, :, None, :], kc)
        o_intra = jnp.einsum('bhts,bhsv->bhtv', scores, vc)
        b_last = b[:, :, -1:, :]
        S_new = jnp.exp(b_last[:, :, 0, :])[..., None] * S + jnp.einsum('bhsk,bhsv->bhkv', kc * jnp.exp(b_last - b), vc)
        return S_new, o_inter + o_intra

    S_fin, o = lax.scan(step, s0.astype(jnp.float32), (chunks(q), chunks(k), chunks(v), chunks(g)))
    return o.transpose(1, 0, 3, 2, 4).reshape(B, L, H, DV), S_fin


def mla_query(c_q, l, p, rope):
    B, L, _ = c_q.shape
    q = (rmsnorm(c_q, p['mla_q_norm_g'][l]) @ p['mla_w_q_up'][l]).reshape(B, L, H_MLA, D_QK)
    q = rmsnorm(q, p['mla_qk_norm_g'][l, 0])
    if rope is not None:
        cos, sin = rope
        q = jnp.concatenate([q[..., :D_NOPE], apply_axial_rope(q[..., D_NOPE:], cos[:, None], sin[:, None])], axis=-1)
    return q


def mla_keys(ckv_n, k_r, l, p, rope):
    B, L, _ = ckv_n.shape
    kv = (ckv_n @ p['mla_w_kv_up'][l]).reshape(B, L, H_MLA, D_NOPE + D_V)
    k_nope, v = kv[..., :D_NOPE], kv[..., D_NOPE:]
    k = jnp.concatenate([k_nope, jnp.broadcast_to(k_r[:, :, None, :], (B, L, H_MLA, D_ROPE)).astype(k_nope.dtype)], axis=-1)
    k = rmsnorm(k, p['mla_qk_norm_g'][l, 1])
    if rope is not None:
        cos, sin = rope
        k = jnp.concatenate([k[..., :D_NOPE], apply_axial_rope(k[..., D_NOPE:], cos[:, None], sin[:, None])], axis=-1)
    return k, v


def mixer(h, l, p, lb, cache, rope):
    B, L, _ = h.shape
    u = h @ p['w_in'][l]
    offsets = [int(o) for o in np.cumsum(IN_SIZES)[:-1]]
    q_h, f_fw, f_bw, v_h, gate_h, c_q, c_kv, k_r, u_f = jnp.split(u, offsets, axis=-1)

    def heads(a):
        return a.reshape(B, L, H_HGRN, -1)
    qh = jax.nn.silu(heads(q_h))
    vh = heads(v_h)
    g_f, k_f = hgrn_gates(heads(f_fw), lb[0].reshape(H_HGRN, DK_HGRN))
    g_b, k_b = hgrn_gates(heads(f_bw), lb[1].reshape(H_HGRN, DK_HGRN))
    if cache is None:
        s_f0 = jnp.zeros((B, H_HGRN, DK_HGRN, DV_HGRN), jnp.float32)
        s_b0 = s_f0
    else:
        s_f0, s_b0 = cache[2], cache[3]
    o_f, s_f = hgrn_scan(qh, k_f, vh, g_f, s_f0)
    o_b, s_b = hgrn_scan(jnp.flip(qh, 1), jnp.flip(k_b, 1), jnp.flip(vh, 1), jnp.flip(g_b, 1), s_b0)
    o_h = (o_f + jnp.flip(o_b, 1)).astype(h.dtype)
    o_hgrn = (rmsnorm(o_h, p['hgrn_norm_g'][l]) * jax.nn.silu(heads(gate_h))).reshape(B, L, W_HGRN)

    ckv_n = rmsnorm(c_kv, p['mla_kv_norm_g'][l])
    q = mla_query(c_q, l, p, rope)
    k, v = mla_keys(ckv_n, k_r, l, p, rope)
    if cache is not None:
        k_c, v_c = mla_keys(cache[0], cache[1], l, p, None)
        k = jnp.concatenate([k_c.astype(k.dtype), k], axis=1)
        v = jnp.concatenate([v_c.astype(v.dtype), v], axis=1)
    o_mla = rmsnorm(block_attention(q, k, v).reshape(B, L, W_MLA), p['mla_out_norm_g'][l])

    uf = u_f.astype(jnp.float32).reshape(B, L, G_FNET, C_FNET)
    spec = jnp.fft.fft2(uf, axes=(1, 3), norm='ortho').real.astype(h.dtype)
    o_fn = jnp.einsum('blgc,gcd->blgd', spec, p['fnet_w'][l]).reshape(B, L, W_FNET)
    o_fnet = rmsnorm(o_fn, p['fnet_norm_g'][l])

    out = jnp.concatenate([o_hgrn, o_mla, o_fnet], axis=-1) @ p['w_out'][l]
    return out, (ckv_n, k_r, s_f, s_b)


def layer_block(x, mod, l, p, lb, cache, rope):
    m = jnp.split(mod, N_MOD, axis=-1)
    h = rmsnorm(x, p['norm_g'][l, 0]) * (1 + m[1]) + m[0]
    x = x + 0.5 * m[2] * swiglu(h, p['ffn_w_gu'][l, 0], p['ffn_w_down'][l, 0])
    h = rmsnorm(x, p['norm_g'][l, 1]) * (1 + m[4]) + m[3]
    o, ctx = mixer(h, l, p, lb, cache, rope)
    x = x + m[5] * o
    h = rmsnorm(x, p['norm_g'][l, 2]) * (1 + m[7]) + m[6]
    x = x + 0.5 * m[8] * swiglu(h, p['ffn_w_gu'][l, 1], p['ffn_w_down'][l, 1])
    return x, ctx


def setup_inputs(seed: int = 0) -> dict:
    key = jax.random.key(seed)
    ks = jax.random.split(key, 24)
    f32 = jnp.float32

    def nrm(k, shape, scale):
        return jax.random.normal(k, shape, f32) * scale

    def gain(k, shape):
        return 1.0 + 0.05 * jax.random.normal(k, shape, f32)

    return {
        'x_prompt': nrm(ks[0], (BATCH, SEQ, D_MODEL), 1.0),
        'x_sample': nrm(ks[1], (DEC_BATCH, DEC_SEQ, D_MODEL), 1.0),
        'cache_ckv': nrm(ks[2], (DEC_BATCH, DEPTH, PAST_LEN, KV_RANK), 1.0),
        'cache_krope': nrm(ks[3], (DEC_BATCH, DEPTH, PAST_LEN, D_ROPE), 1.0),
        'state_hgrn': nrm(ks[4], (DEC_BATCH, DEPTH, 2, H_HGRN, DK_HGRN, DV_HGRN), 0.5),
        'c': nrm(ks[5], (DEC_BATCH, D_MODEL), 1.0),
        'c_ctx': nrm(ks[6], (D_MODEL,), 1.0),
        'ada_w': nrm(ks[7], (DEPTH, D_MODEL, N_MOD * D_MODEL), 0.5 * D_MODEL ** -0.5),
        'ada_b': nrm(ks[8], (DEPTH, N_MOD * D_MODEL), 0.01),
        'norm_g': gain(ks[9], (DEPTH, 3, D_MODEL)),
        'ffn_w_gu': nrm(ks[10], (DEPTH, 2, D_MODEL, 2 * D_FF), D_MODEL ** -0.5),
        'ffn_w_down': nrm(ks[11], (DEPTH, 2, D_FF, D_MODEL), D_FF ** -0.5),
        'w_in': nrm(ks[12], (DEPTH, D_MODEL, IN_WIDTH), D_MODEL ** -0.5),
        'hgrn_lb': nrm(ks[13], (DEPTH, 2, H_HGRN * DK_HGRN), 0.5),
        'hgrn_norm_g': gain(ks[14], (DEPTH, DV_HGRN)),
        'mla_q_norm_g': gain(ks[15], (DEPTH, Q_RANK)),
        'mla_w_q_up': nrm(ks[16], (DEPTH, Q_RANK, H_MLA * D_QK), Q_RANK ** -0.5),
        'mla_kv_norm_g': gain(ks[17], (DEPTH, KV_RANK)),
        'mla_w_kv_up': nrm(ks[18], (DEPTH, KV_RANK, H_MLA * (D_NOPE + D_V)), KV_RANK ** -0.5),
        'mla_qk_norm_g': gain(ks[19], (DEPTH, 2, D_QK)),
        'mla_out_norm_g': gain(ks[20], (DEPTH, W_MLA)),
        'fnet_w': nrm(ks[21], (DEPTH, G_FNET, C_FNET, C_FNET), C_FNET ** -0.5),
        'fnet_norm_g': gain(ks[22], (DEPTH, W_FNET)),
        'w_out': nrm(ks[23], (DEPTH, MIX_WIDTH, D_MODEL), MIX_WIDTH ** -0.5),
    }


def reference(x_prompt, x_sample, cache_ckv, cache_krope, state_hgrn, c, c_ctx, ada_w, ada_b, norm_g,
              ffn_w_gu, ffn_w_down, w_in, hgrn_lb, hgrn_norm_g, mla_q_norm_g, mla_w_q_up, mla_kv_norm_g,
              mla_w_kv_up, mla_qk_norm_g, mla_out_norm_g, fnet_w, fnet_norm_g, w_out):
    p = dict(norm_g=norm_g, ffn_w_gu=ffn_w_gu, ffn_w_down=ffn_w_down, w_in=w_in, hgrn_norm_g=hgrn_norm_g,
             mla_q_norm_g=mla_q_norm_g, mla_w_q_up=mla_w_q_up, mla_kv_norm_g=mla_kv_norm_g,
             mla_w_kv_up=mla_w_kv_up, mla_qk_norm_g=mla_qk_norm_g, mla_out_norm_g=mla_out_norm_g,
             fnet_w=fnet_w, fnet_norm_g=fnet_norm_g, w_out=w_out)
    lbs = jnp.cumsum(jax.nn.softmax(hgrn_lb.astype(jnp.float32), axis=0), axis=0)
    lbs = lbs - lbs[:1]
    rope = axial_rope_tables(x_sample.shape[1])

    x_ctx = x_prompt
    x_lat = x_sample
    ckv_list, kr_list, st_list = [], [], []
    for l in range(DEPTH):
        mod_ctx = (jax.nn.silu(c_ctx) @ ada_w[l] + ada_b[l])[None, None, :]
        x_ctx, (ckv, kr, s_f, s_b) = layer_block(x_ctx, mod_ctx, l, p, lbs[l], None, None)
        ckv_list.append(ckv)
        kr_list.append(kr)
        st_list.append(jnp.stack([s_f, s_b], axis=1))

        mod_lat = (jax.nn.silu(c) @ ada_w[l] + ada_b[l])[:, None, :]
        cache_l = (cache_ckv[:, l], cache_krope[:, l], state_hgrn[:, l, 0], state_hgrn[:, l, 1])
        x_lat, _ = layer_block(x_lat, mod_lat, l, p, lbs[l], cache_l, rope)

    new_cache_ckv = jnp.stack(ckv_list, axis=1)
    new_cache_krope = jnp.stack(kr_list, axis=1)
    new_state_hgrn = jnp.stack(st_list, axis=1)
    return (x_ctx, x_lat, new_cache_ckv, new_cache_krope, new_state_hgrn)
```

```cpp
#include <hip/hip_runtime.h>
#include <hip/hip_cooperative_groups.h>
#include <stdint.h>
#include <stdio.h>
namespace cg = cooperative_groups;

#ifndef MEGA
#define MEGA 1
#endif

typedef unsigned short u16;
typedef __attribute__((ext_vector_type(8))) short bf16x8;
typedef __attribute__((ext_vector_type(4))) float f32x4;
typedef __attribute__((ext_vector_type(16))) float f32x16;
#define DI __device__ __forceinline__

constexpr int T = 16384, TC = 8192, DM = 1024, DFF = 2816, NGU = 5632, NIN = 2208, NINP = 2304;
constexpr int TK = 17408;
constexpr float EPS = 1e-6f;
constexpr int SMEM_BYTES = 65536;

constexpr size_t al(size_t x) { return (x + 255) & ~(size_t)255; }
constexpr size_t O_WGU = 0;
constexpr size_t O_WDN = O_WGU + al((size_t)4 * NGU * DM * 2);
constexpr size_t O_WIN = O_WDN + al((size_t)4 * DM * DFF * 2);
constexpr size_t O_WQ = O_WIN + al((size_t)2 * NINP * DM * 2);
constexpr size_t O_WKV = O_WQ + al((size_t)2 * 768 * 384 * 2);
constexpr size_t O_WO = O_WKV + al((size_t)2 * 1024 * 256 * 2);
constexpr size_t O_WF = O_WO + al((size_t)2 * 1024 * 1024 * 2);
constexpr size_t O_MOD = O_WF + al((size_t)2 * 256 * 512 * 2);
constexpr size_t O_TAB = O_MOD + al((size_t)2 * 3 * 9216 * 4);
constexpr int TAB_W64 = 4944, TAB_W16 = 4944 + 4096, TAB_N = 4944 + 4096 + 256;
constexpr size_t O_H = O_TAB + al((size_t)TAB_N * 8);
constexpr size_t O_BIG = O_H + al((size_t)T * DM * 2);
constexpr size_t SZ_BIG = al((size_t)T * 1280 * 2) + al((size_t)T * 928 * 4);
constexpr size_t O_UBF = O_BIG;
constexpr size_t O_UM = O_BIG + al((size_t)T * 1280 * 2);
constexpr size_t O_C1 = O_BIG + SZ_BIG;
constexpr size_t O_CQN = O_C1;
constexpr size_t O_CKVN = O_CQN + al((size_t)T * 384 * 2);
constexpr size_t O_YFFT = O_CKVN + al((size_t)TK * 256 * 2);
constexpr size_t E_C1A = O_YFFT + al((size_t)T * 256 * 8);
constexpr size_t O_OMLA = O_C1;
constexpr size_t O_OF = O_OMLA + al((size_t)T * 512 * 2);
constexpr size_t O_OB = O_OF + al((size_t)T * 256 * 4);
constexpr size_t O_OFN = O_OB + al((size_t)T * 256 * 4);
constexpr size_t E_C1B = O_OFN + al((size_t)T * 256 * 2);
constexpr size_t O_C2 = (E_C1A > E_C1B ? E_C1A : E_C1B);
constexpr size_t O_KBUF = O_C2;
constexpr size_t O_VT = O_KBUF + al((size_t)TK * 8 * 96 * 2);
constexpr size_t O_XBUF = O_VT + al((size_t)TK * 8 * 64 * 2);
constexpr size_t O_SLOC = O_XBUF + al((size_t)T * 512 * 2);
constexpr size_t O_DTOT = O_SLOC + al((size_t)1024 * 4096 * 4);
constexpr size_t O_KRR = O_DTOT + al((size_t)1024 * 64 * 4);
constexpr size_t O_KRSS = O_KRR + al((size_t)TK * 32 * 4);
constexpr size_t O_BAR = O_KRSS + al((size_t)TK * 4);
constexpr size_t O_SIN = O_H + (size_t)T * 768 * 2;
static_assert((size_t)T * 768 * 2 + (size_t)512 * 4096 * 4 <= (size_t)T * DM * 2, "sin fits behind qraw");
constexpr size_t WS_TOTAL = O_BAR + al((size_t)3456 * 4);
static_assert(WS_TOTAL <= (size_t)369098752, "workspace too large");
static_assert((size_t)T * DFF * 2 <= SZ_BIG, "act fits");
static_assert((size_t)T * 768 * 2 <= (size_t)T * DM * 2, "qraw fits in h");

constexpr size_t OUT_X = 0;
constexpr size_t OUT_CKV = (size_t)T * DM;
constexpr size_t OUT_KR = OUT_CKV + (size_t)32 * 2 * 256 * 256;
constexpr size_t OUT_ST = OUT_KR + (size_t)32 * 2 * 256 * 32;

struct Params {
  const float *x_prompt, *x_sample, *cache_ckv, *cache_krope, *state_hgrn, *c, *c_ctx, *ada_w, *ada_b, *norm_g;
  const float *ffn_w_gu, *ffn_w_down, *w_in, *hgrn_lb, *hgrn_norm_g, *mla_q_norm_g, *mla_w_q_up, *mla_kv_norm_g;
  const float *mla_w_kv_up, *mla_qk_norm_g, *mla_out_norm_g, *fnet_w, *fnet_norm_g, *w_out;
  float* out;
  char* ws;
};

typedef unsigned u32x4 __attribute__((ext_vector_type(4)));
#define GLOAD16(dst, ptr) asm volatile("global_load_dwordx4 %0, %1, off" : "=v"(dst) : "v"(ptr) : "memory")
#define VMWAIT0() asm volatile("s_waitcnt vmcnt(0)" ::: "memory")
#define GLOAD4(dst, ptr) asm volatile("global_load_dword %0, %1, off" : "=v"(dst) : "v"(ptr) : "memory")
#define GLOAD8(dst, ptr) asm volatile("global_load_dwordx2 %0, %1, off" : "=v"(dst) : "v"(ptr) : "memory")
DI int tid_() { int t = threadIdx.x; asm volatile("" : "+v"(t)); return t; }
DI int bid_() { int t = blockIdx.x; asm volatile("" : "+s"(t)); return t; }
DI u16 f2bf(float x) { __bf16 h = (__bf16)x; return __builtin_bit_cast(u16, h); }
DI float bf2f(u16 h) { return __uint_as_float(((unsigned)h) << 16); }
typedef __bf16 bf16x2_t __attribute__((ext_vector_type(2)));
typedef float f32x2_t __attribute__((ext_vector_type(2)));
DI unsigned pack2(float a, float b) { f32x2_t v = {a, b}; bf16x2_t r = __builtin_convertvector(v, bf16x2_t); return __builtin_bit_cast(unsigned, r); }
DI float wave_sum(float v) {
#pragma unroll
  for (int o = 32; o > 0; o >>= 1) v += __shfl_xor(v, o);
  return v;
}
DI int cond_of(int row) { return row < TC ? 0 : 1 + ((row - TC) >> 12); }
DI float sigmoidf_(float x) { return __builtin_amdgcn_rcpf(1.f + __expf(-x)); }

template <class Epi>
DI void gemm_tile(const u16* __restrict__ A, int lda, const u16* __restrict__ Bt, int ldb, int K, int m0, int n0,
                  char* smem, Epi epi) {
  const int tid = tid_(), lane = tid & 63, wid = tid >> 6, wm = wid >> 1, wn = wid & 1;
  const int l15 = lane & 15, quad = lane >> 4;
  f32x4 acc[4][4];
#pragma unroll
  for (int i = 0; i < 4; ++i)
#pragma unroll
    for (int j = 0; j < 4; ++j) acc[i][j] = (f32x4){0.f, 0.f, 0.f, 0.f};
  const int lrow = tid >> 3;
  const int gch = (tid & 7) ^ ((tid >> 4) & 7);
  const u16* ga = A + (size_t)(m0 + lrow) * lda + gch * 8;
  const u16* gb = Bt + (size_t)(n0 + lrow) * ldb + gch * 8;
  const int nk = K >> 6;
#define GEMM_GLDS(KT, BUF)                                                                                     \
  {                                                                                                            \
    char* d_ = smem + (BUF) * 32768 + tid * 16;                                                                \
    _Pragma("unroll") for (int i = 0; i < 4; ++i) {                                                            \
      __builtin_amdgcn_global_load_lds((const unsigned*)(ga + (size_t)i * 32 * lda + (KT) * 64),               \
                                       (unsigned*)(d_ + i * 4096), 16, 0, 0);                                  \
      __builtin_amdgcn_global_load_lds((const unsigned*)(gb + (size_t)i * 32 * ldb + (KT) * 64),               \
                                       (unsigned*)(d_ + 16384 + i * 4096), 16, 0, 0);                          \
    }                                                                                                          \
  }
  GEMM_GLDS(0, 0)
  asm volatile("s_waitcnt vmcnt(0)" ::: "memory");
  __builtin_amdgcn_s_barrier(); asm volatile("" ::: "memory");
  const unsigned lds0 = (unsigned)(size_t)smem;
  const int sw_ = (l15 >> 1) & 7;
  const unsigned ab0 = lds0 + (wm * 64 + l15) * 128 + ((quad ^ sw_) << 4);
  const unsigned ab1 = lds0 + (wm * 64 + l15) * 128 + (((4 + quad) ^ sw_) << 4);
  const unsigned bb0 = lds0 + 16384 + (wn * 64 + l15) * 128 + ((quad ^ sw_) << 4);
  const unsigned bb1 = lds0 + 16384 + (wn * 64 + l15) * 128 + (((4 + quad) ^ sw_) << 4);
#define DSR(dst, addr, OFF) asm volatile("ds_read_b128 %0, %1 offset:" #OFF : "=v"(dst) : "v"(addr) : "memory")
#define GEMM_MMA(AF, BF)                                                                     \
  _Pragma("unroll") for (int mi = 0; mi < 4; ++mi)                                           \
    _Pragma("unroll") for (int ni = 0; ni < 4; ++ni)                                         \
      acc[mi][ni] = __builtin_amdgcn_mfma_f32_16x16x32_bf16(AF[mi], BF[ni], acc[mi][ni], 0, 0, 0);
#define GEMM_WAIT(N, AF, BF)                                                                 \
  asm volatile("s_waitcnt lgkmcnt(" #N ")" : "+v"(AF[0]), "+v"(AF[1]), "+v"(AF[2]), "+v"(AF[3]), "+v"(BF[0]), "+v"(BF[1]), "+v"(BF[2]), "+v"(BF[3]) :: "memory");
#define GEMM_COMPUTE(O0, O1, O2, O3)                                                         \
  {                                                                                          \
    bf16x8 a0[4], b0[4], a1[4], b1[4];                                                       \
    DSR(a0[0], ab0, O0); DSR(a0[1], ab0, O1); DSR(a0[2], ab0, O2); DSR(a0[3], ab0, O3);      \
    DSR(b0[0], bb0, O0); DSR(b0[1], bb0, O1); DSR(b0[2], bb0, O2); DSR(b0[3], bb0, O3);      \
    DSR(a1[0], ab1, O0); DSR(a1[1], ab1, O1); DSR(a1[2], ab1, O2); DSR(a1[3], ab1, O3);      \
    DSR(b1[0], bb1, O0); DSR(b1[1], bb1, O1); DSR(b1[2], bb1, O2); DSR(b1[3], bb1, O3);      \
    GEMM_WAIT(8, a0, b0)                                                                     \
    __builtin_amdgcn_s_setprio(1);                                                           \
    GEMM_MMA(a0, b0)                                                                         \
    __builtin_amdgcn_sched_barrier(0);                                                       \
    GEMM_WAIT(0, a1, b1)                                                                     \
    GEMM_MMA(a1, b1)                                                                         \
    __builtin_amdgcn_s_setprio(0);                                                           \
    __builtin_amdgcn_sched_barrier(0);                                                       \
  }
  for (int kt = 0; kt < nk; kt += 2) {
    GEMM_GLDS(kt + 1, 1)
    GEMM_COMPUTE(0, 2048, 4096, 6144)
    asm volatile("s_waitcnt vmcnt(0)" ::: "memory");
    __builtin_amdgcn_s_barrier(); asm volatile("" ::: "memory");
    if (kt + 2 < nk) GEMM_GLDS(kt + 2, 0)
    GEMM_COMPUTE(32768, 34816, 36864, 38912)
    asm volatile("s_waitcnt vmcnt(0)" ::: "memory");
    __builtin_amdgcn_s_barrier(); asm volatile("" ::: "memory");
  }
  epi(acc, m0 + wm * 64, n0 + wn * 64, lane);
}

DI void tile_mn(int t, int nM, int nN, int& mt, int& nt) {
  int per = 16 * nN;
  int g = t / per, r = t - g * per;
  int gm = nM - g * 16; if (gm > 16) gm = 16;
  mt = g * 16 + (r % gm);
  nt = r / gm;
}

DI void transpose_tile(const float* __restrict__ src, int K, int N, u16* __restrict__ dst, int kt, int nt, int mode,
                       float* tile) {
  const int tid = tid_();
  const int k0 = kt * 64, n0 = nt * 64;
  {
    const int n = tid & 63;
    const bool inb = n0 + n < N;
    const float* sp = src + (size_t)(k0 + (tid >> 6)) * N + (inb ? n0 + n : 0);
    float tv[16];
#pragma unroll
    for (int i = 0; i < 16; ++i) GLOAD4(tv[i], sp + (size_t)(i * 4) * N);
    asm volatile("s_waitcnt vmcnt(0)" : "+v"(tv[0]), "+v"(tv[1]), "+v"(tv[2]), "+v"(tv[3]), "+v"(tv[4]), "+v"(tv[5]), "+v"(tv[6]), "+v"(tv[7]),
                 "+v"(tv[8]), "+v"(tv[9]), "+v"(tv[10]), "+v"(tv[11]), "+v"(tv[12]), "+v"(tv[13]), "+v"(tv[14]), "+v"(tv[15]) :: "memory");
#pragma unroll
    for (int i = 0; i < 16; ++i) tile[(i * 4 + (tid >> 6)) * 65 + n] = inb ? tv[i] : 0.f;
  }
  __syncthreads();
  const int nl = tid >> 2, ks = (tid & 3) * 16;
  int n = n0 + nl, nd = n;
  if (mode == 1) {
    if (n < DFF) nd = (n >> 4) * 32 + (n & 15);
    else { int c = n - DFF; nd = (c >> 4) * 32 + 16 + (c & 15); }
  }
  unsigned pk[8];
#pragma unroll
  for (int j = 0; j < 8; ++j) pk[j] = pack2(tile[(ks + 2 * j) * 65 + nl], tile[(ks + 2 * j + 1) * 65 + nl]);
  uint4* d = (uint4*)(dst + (size_t)nd * K + k0 + ks);
  d[0] = make_uint4(pk[0], pk[1], pk[2], pk[3]);
  d[1] = make_uint4(pk[4], pk[5], pk[6], pk[7]);
  __syncthreads();
}

constexpr int NT_WGU = 4 * 16 * 88, NT_WDN = 4 * 44 * 16, NT_WIN = 2 * 16 * 36, NT_WQ = 2 * 6 * 12, NT_WKV = 2 * 4 * 16,
              NT_WO = 2 * 16 * 16;
constexpr int NT_TR = NT_WGU + NT_WDN + NT_WIN + NT_WQ + NT_WKV + NT_WO;
constexpr int NT_WF = 1024, NT_MOD = 288, NT_TAB = 1;
constexpr int NT_PREP = NT_TR + NT_WF + NT_MOD + NT_TAB;

DI void phase_prep(const Params& p, char* smem) {
  const int tid = tid_();
  float* fs = (float*)smem;
  for (int it = bid_(); it < NT_PREP; it += gridDim.x) {
    int t = it;
    if (t < NT_TR) {
      if (t < NT_WGU) {
        int m = t / (16 * 88), r = t % (16 * 88);
        transpose_tile(p.ffn_w_gu + (size_t)m * DM * NGU, DM, NGU, (u16*)(p.ws + O_WGU) + (size_t)m * NGU * DM, r / 88,
                       r % 88, 1, fs);
        continue;
      }
      t -= NT_WGU;
      if (t < NT_WDN) {
        int m = t / (44 * 16), r = t % (44 * 16);
        transpose_tile(p.ffn_w_down + (size_t)m * DFF * DM, DFF, DM, (u16*)(p.ws + O_WDN) + (size_t)m * DM * DFF, r / 16,
                       r % 16, 0, fs);
        continue;
      }
      t -= NT_WDN;
      if (t < NT_WIN) {
        int m = t / (16 * 36), r = t % (16 * 36);
        transpose_tile(p.w_in + (size_t)m * DM * NIN, DM, NIN, (u16*)(p.ws + O_WIN) + (size_t)m * NINP * DM, r / 36,
                       r % 36, 0, fs);
        continue;
      }
      t -= NT_WIN;
      if (t < NT_WQ) {
        int m = t / 72, r = t % 72;
        transpose_tile(p.mla_w_q_up + (size_t)m * 384 * 768, 384, 768, (u16*)(p.ws + O_WQ) + (size_t)m * 768 * 384, r / 12,
                       r % 12, 0, fs);
        continue;
      }
      t -= NT_WQ;
      if (t < NT_WKV) {
        int m = t / 64, r = t % 64;
        transpose_tile(p.mla_w_kv_up + (size_t)m * 256 * 1024, 256, 1024, (u16*)(p.ws + O_WKV) + (size_t)m * 1024 * 256,
                       r / 16, r % 16, 0, fs);
        continue;
      }
      t -= NT_WKV;
      {
        int m = t / 256, r = t % 256;
        transpose_tile(p.w_out + (size_t)m * DM * DM, DM, DM, (u16*)(p.ws + O_WO) + (size_t)m * DM * DM, r / 16, r % 16, 0,
                       fs);
        continue;
      }
    }
    t -= NT_TR;
    if (t < NT_WF) {
      int e = t * 256 + tid;
      int l = e >> 17, r = e & 131071;
      int nrow = r >> 9, kcol = r & 511;
      int g = nrow >> 6, d = nrow & 63, g2 = kcol >> 7, part = (kcol >> 6) & 1, c = kcol & 63;
      float v = 0.f;
      if (g == g2) {
        const float* fw = p.fnet_w + ((size_t)(l * 4 + g) * 64) * 64 + d;
        float fv[64];
#pragma unroll
        for (int m = 0; m < 64; ++m) GLOAD4(fv[m], fw + m * 64);
#pragma unroll
        for (int m = 0; m < 64; m += 8)
          asm volatile("s_waitcnt vmcnt(0)" : "+v"(fv[m]), "+v"(fv[m + 1]), "+v"(fv[m + 2]), "+v"(fv[m + 3]), "+v"(fv[m + 4]), "+v"(fv[m + 5]), "+v"(fv[m + 6]), "+v"(fv[m + 7]) :: "memory");
#pragma unroll
        for (int m = 0; m < 64; ++m) {
          int idx = (m * c) & 63;
          float ang = (float)idx * (6.283185307179586f / 64.f);
          float w = part ? __sinf(ang) : __cosf(ang);
          v += w * fv[m];
        }
      }
      ((u16*)(p.ws + O_WF))[e] = f2bf(v);
      continue;
    }
    t -= NT_WF;
    if (t < NT_MOD) {
      int l = t / 144, cb = t % 144;
      float* sc = fs;
      float* red = fs + 3072;
      for (int i = tid; i < 3072; i += 256) {
        int cnd = i >> 10, k = i & 1023;
        float v = cnd == 0 ? p.c_ctx[k] : p.c[(cnd - 1) * 1024 + k];
        sc[i] = v * sigmoidf_(v);
      }
      __syncthreads();
      int kq = tid >> 4, cq = tid & 15;
      float a[3][4];
#pragma unroll
      for (int i = 0; i < 3; ++i)
#pragma unroll
        for (int j = 0; j < 4; ++j) a[i][j] = 0.f;
      const float* wbase = p.ada_w + (size_t)l * 1024 * 9216 + cb * 64 + cq * 4;
      for (int k0 = kq; k0 < 1024; k0 += 128) {
        u32x4 wv[8];
#pragma unroll
        for (int j = 0; j < 8; ++j) GLOAD16(wv[j], wbase + (size_t)(k0 + 16 * j) * 9216);
        asm volatile("s_waitcnt vmcnt(0)" : "+v"(wv[0]), "+v"(wv[1]), "+v"(wv[2]), "+v"(wv[3]), "+v"(wv[4]), "+v"(wv[5]), "+v"(wv[6]), "+v"(wv[7]) :: "memory");
#pragma unroll
        for (int j = 0; j < 8; ++j) {
          const int k = k0 + 16 * j;
          const float wx = __uint_as_float(wv[j][0]), wy = __uint_as_float(wv[j][1]), wz = __uint_as_float(wv[j][2]), ww = __uint_as_float(wv[j][3]);
#pragma unroll
          for (int i = 0; i < 3; ++i) {
            float s = sc[i * 1024 + k];
            a[i][0] += s * wx; a[i][1] += s * wy; a[i][2] += s * wz; a[i][3] += s * ww;
          }
        }
      }
#pragma unroll
      for (int i = 0; i < 3; ++i)
#pragma unroll
        for (int j = 0; j < 4; ++j) red[(kq * 3 + i) * 64 + cq * 4 + j] = a[i][j];
      __syncthreads();
      if (tid < 192) {
        int i = tid >> 6, col = tid & 63;
        float s = 0.f;
        for (int q = 0; q < 16; ++q) s += red[(q * 3 + i) * 64 + col];
        int cc = cb * 64 + col;
        ((float*)(p.ws + O_MOD))[(size_t)(l * 3 + i) * 9216 + cc] = s + p.ada_b[l * 9216 + cc];
      }
      __syncthreads();
      continue;
    }
    t -= NT_MOD;
    {
      float2* tab = (float2*)(p.ws + O_TAB);
      for (int i = tid; i < TAB_N; i += 256) {
        int n, L;
        float ang;
        if (i < 4432) {
          if (i < 16) { n = i; L = 16; }
          else if (i < 80) { n = i - 16; L = 64; }
          else if (i < 336) { n = i - 80; L = 256; }
          else { n = i - 336; L = 4096; }
          ang = (float)n * (6.283185307179586f / (float)L);
        } else if (i < TAB_W64) {
          int e = i - 4432;
          float freq = exp2f(-(float)(e & 7) * (13.287712379549449f / 8.f));
          ang = (float)(e >> 3) * freq;
        } else if (i < TAB_W16) {
          int e = i - TAB_W64;
          ang = (float)(((e >> 6) * (e & 63)) & 63) * (6.283185307179586f / 64.f);
        } else {
          int e = i - TAB_W16;
          ang = (float)(((e >> 4) * (e & 15)) & 15) * (6.283185307179586f / 16.f);
        }
        tab[i] = make_float2(cosf(ang), sinf(ang));
      }
    }
  }
}

DI void phase_norm(const Params& p, int l, int idx, bool first) {
  const int tid = tid_(), lane = tid & 63, wid = tid >> 6;
  const float* mod = (const float*)(p.ws + O_MOD) + (size_t)l * 3 * 9216;
  const float* g = p.norm_g + (size_t)(l * 3 + idx) * 1024;
  u16* h = (u16*)(p.ws + O_H);
  for (int rb = bid_(); rb < T / 8; rb += gridDim.x) {
    float4 v[2][4];
    float ss[2];
#pragma unroll
    for (int q = 0; q < 2; ++q) {
      const int row = rb * 8 + q * 4 + wid;
      const float* src = first ? (row < TC ? p.x_prompt + (size_t)row * DM : p.x_sample + (size_t)(row - TC) * DM)
                               : p.out + (size_t)row * DM;
#pragma unroll
      for (int i = 0; i < 4; ++i) v[q][i] = *(const float4*)(src + i * 256 + lane * 4);
    }
#pragma unroll
    for (int q = 0; q < 2; ++q) {
      float s = 0.f;
#pragma unroll
      for (int i = 0; i < 4; ++i) s += v[q][i].x * v[q][i].x + v[q][i].y * v[q][i].y + v[q][i].z * v[q][i].z + v[q][i].w * v[q][i].w;
      ss[q] = s;
    }
#pragma unroll
    for (int o = 32; o > 0; o >>= 1) { ss[0] += __shfl_xor(ss[0], o); ss[1] += __shfl_xor(ss[1], o); }
    u32x4 pg[4], psc[2][4], psh[2][4];
#pragma unroll
    for (int i = 0; i < 4; ++i) GLOAD16(pg[i], g + i * 256 + lane * 4);
#pragma unroll
    for (int q = 0; q < 2; ++q) {
      const int row = rb * 8 + q * 4 + wid;
      const float* mc = mod + (size_t)cond_of(row) * 9216;
#pragma unroll
      for (int i = 0; i < 4; ++i) {
        GLOAD16(psc[q][i], mc + (3 * idx + 1) * 1024 + i * 256 + lane * 4);
        GLOAD16(psh[q][i], mc + (3 * idx) * 1024 + i * 256 + lane * 4);
      }
    }
    asm volatile("s_waitcnt vmcnt(0)" : "+v"(pg[0]), "+v"(pg[1]), "+v"(pg[2]), "+v"(pg[3]) :: "memory");
    asm volatile("" : "+v"(psc[0][0]), "+v"(psc[0][1]), "+v"(psc[0][2]), "+v"(psc[0][3]), "+v"(psc[1][0]), "+v"(psc[1][1]), "+v"(psc[1][2]), "+v"(psc[1][3]) :: "memory");
    asm volatile("" : "+v"(psh[0][0]), "+v"(psh[0][1]), "+v"(psh[0][2]), "+v"(psh[0][3]), "+v"(psh[1][0]), "+v"(psh[1][1]), "+v"(psh[1][2]), "+v"(psh[1][3]) :: "memory");
#pragma unroll
    for (int q = 0; q < 2; ++q) {
      const int row = rb * 8 + q * 4 + wid;
      const float rstd = rsqrtf(ss[q] * (1.f / 1024.f) + EPS);
#pragma unroll
      for (int i = 0; i < 4; ++i) {
        int col = i * 256 + lane * 4;
        float a = v[q][i].x * rstd * __uint_as_float(pg[i][0]) * (1.f + __uint_as_float(psc[q][i][0])) + __uint_as_float(psh[q][i][0]);
        float b = v[q][i].y * rstd * __uint_as_float(pg[i][1]) * (1.f + __uint_as_float(psc[q][i][1])) + __uint_as_float(psh[q][i][1]);
        float c = v[q][i].z * rstd * __uint_as_float(pg[i][2]) * (1.f + __uint_as_float(psc[q][i][2])) + __uint_as_float(psh[q][i][2]);
        float d = v[q][i].w * rstd * __uint_as_float(pg[i][3]) * (1.f + __uint_as_float(psc[q][i][3])) + __uint_as_float(psh[q][i][3]);
        *(uint2*)(h + (size_t)row * DM + col) = make_uint2(pack2(a, b), pack2(c, d));
        if (first) *(float4*)(p.out + (size_t)row * DM + col) = v[q][i];
      }
    }
  }
}

DI void phase_ffn_gu(const Params& p, int l, int f, char* smem) {
  const u16* A = (const u16*)(p.ws + O_H);
  const u16* Bt = (const u16*)(p.ws + O_WGU) + (size_t)(l * 2 + f) * NGU * DM;
  u16* act = (u16*)(p.ws + O_BIG);
  auto epi = [&](f32x4 (&acc)[4][4], int mb, int nb, int lane) {
    const int l15 = lane & 15, quad = lane >> 4;
#pragma unroll
    for (int mi = 0; mi < 4; ++mi)
#pragma unroll
      for (int pq = 0; pq < 2; ++pq) {
        int c = ((nb >> 5) + pq) * 16 + l15;
#pragma unroll
        for (int j = 0; j < 4; ++j) {
          int row = mb + mi * 16 + quad * 4 + j;
          float gt = acc[mi][2 * pq][j], up = acc[mi][2 * pq + 1][j];
          act[(size_t)row * DFF + c] = f2bf(gt * sigmoidf_(gt) * up);
        }
      }
  };
  const int nM = T / 128, nN = NGU / 128;
  for (int t = bid_(); t < nM * nN; t += gridDim.x) {
    int mt, nt; tile_mn(t, nM, nN, mt, nt);
    gemm_tile(A, DM, Bt, DM, DM, mt * 128, nt * 128, smem, epi);
  }
}

DI void phase_gemm_resid(const Params& p, const u16* A, int K, const u16* Bt, int l, int gidx, float coef, char* smem) {
  const float* mod = (const float*)(p.ws + O_MOD) + (size_t)l * 3 * 9216 + (size_t)gidx * 1024;
  float* x = p.out;
  auto epi = [&](f32x4 (&acc)[4][4], int mb, int nb, int lane) {
    const int l15 = lane & 15, quad = lane >> 4;
    const float* gm = mod + (size_t)cond_of(mb) * 9216;
#pragma unroll
    for (int ni = 0; ni < 4; ++ni) {
      int col = nb + ni * 16 + l15;
      float gt = coef * gm[col];
      float* xp = x + (size_t)(mb + quad * 4) * DM + col;
      float xv[16];
#pragma unroll
      for (int mi = 0; mi < 4; ++mi)
#pragma unroll
        for (int j = 0; j < 4; ++j) GLOAD4(xv[mi * 4 + j], xp + (size_t)(mi * 16 + j) * DM);
      asm volatile("s_waitcnt vmcnt(0)" : "+v"(xv[0]), "+v"(xv[1]), "+v"(xv[2]), "+v"(xv[3]), "+v"(xv[4]), "+v"(xv[5]), "+v"(xv[6]), "+v"(xv[7]),
                   "+v"(xv[8]), "+v"(xv[9]), "+v"(xv[10]), "+v"(xv[11]), "+v"(xv[12]), "+v"(xv[13]), "+v"(xv[14]), "+v"(xv[15]) :: "memory");
#pragma unroll
      for (int mi = 0; mi < 4; ++mi)
#pragma unroll
        for (int j = 0; j < 4; ++j) xp[(size_t)(mi * 16 + j) * DM] = xv[mi * 4 + j] + gt * acc[mi][ni][j];
    }
  };
  const int nM = T / 128, nN = DM / 128;
  for (int t = bid_(); t < nM * nN; t += gridDim.x) {
    int mt, nt; tile_mn(t, nM, nN, mt, nt);
    gemm_tile(A, K, Bt, K, K, mt * 128, nt * 128, smem, epi);
  }
}

DI void phase_win(const Params& p, int l, char* smem) {
  const u16* A = (const u16*)(p.ws + O_H);
  const u16* Bt = (const u16*)(p.ws + O_WIN) + (size_t)l * NINP * DM;
  u16* ubf = (u16*)(p.ws + O_UBF);
  float* um = (float*)(p.ws + O_UM);
  auto epi = [&](f32x4 (&acc)[4][4], int mb, int nb, int lane) {
    const int l15 = lane & 15, quad = lane >> 4;
#pragma unroll
    for (int ni = 0; ni < 4; ++ni) {
      int col = nb + ni * 16 + l15;
#pragma unroll
      for (int mi = 0; mi < 4; ++mi)
#pragma unroll
        for (int j = 0; j < 4; ++j) {
          int row = mb + mi * 16 + quad * 4 + j;
          if (col < 1280) ubf[(size_t)row * 1280 + col] = f2bf(acc[mi][ni][j]);
          else if (col < NIN) um[(size_t)row * 928 + (col - 1280)] = acc[mi][ni][j];
        }
    }
  };
  const int nM = T / 128, nN = NINP / 128;
  for (int t = bid_(); t < nM * nN; t += gridDim.x) {
    int mt, nt; tile_mn(t, nM, nN, mt, nt);
    gemm_tile(A, DM, Bt, DM, DM, mt * 128, nt * 128, smem, epi);
  }
}

DI void mixprep_rows(const Params& p, int l, int item) {
  const int tid = tid_(), lane = tid & 63, wid = tid >> 6;
  int row = item * 4 + wid;
  u16* cqn = (u16*)(p.ws + O_CQN);
  u16* ckvn = (u16*)(p.ws + O_CKVN);
  float* krr = (float*)(p.ws + O_KRR);
  float* krss = (float*)(p.ws + O_KRSS);
  const float* g1 = p.mla_qk_norm_g + (size_t)(l * 2 + 1) * 96;
  if (row < T) {
    const float* um = (const float*)(p.ws + O_UM) + (size_t)row * 928;
    float lq_[6], lgq_[6], lkr_, lg1_; u32x4 lkv_, lgkv_; f32x2_t lcs_;
    const int jj_ = lane & 31;
    int rpos_ = 0;
    if (row >= TC) { int tpos = (row - TC) & 4095; rpos_ = (jj_ >> 4) == 0 ? (tpos >> 6) : (tpos & 63); }
#pragma unroll
    for (int i = 0; i < 6; ++i) { GLOAD4(lq_[i], um + i * 64 + lane); GLOAD4(lgq_[i], p.mla_q_norm_g + l * 384 + i * 64 + lane); }
    GLOAD16(lkv_, um + 384 + lane * 4);
    GLOAD16(lgkv_, p.mla_kv_norm_g + l * 256 + lane * 4);
    GLOAD4(lkr_, um + 640 + jj_);
    GLOAD4(lg1_, g1 + 64 + jj_);
    GLOAD8(lcs_, (const float2*)(p.ws + O_TAB) + 4432 + rpos_ * 8 + (jj_ & 7));
    asm volatile("s_waitcnt vmcnt(0)" : "+v"(lq_[0]), "+v"(lq_[1]), "+v"(lq_[2]), "+v"(lq_[3]), "+v"(lq_[4]), "+v"(lq_[5]),
                 "+v"(lgq_[0]), "+v"(lgq_[1]), "+v"(lgq_[2]), "+v"(lgq_[3]), "+v"(lgq_[4]), "+v"(lgq_[5]),
                 "+v"(lkv_), "+v"(lgkv_), "+v"(lkr_), "+v"(lg1_), "+v"(lcs_) :: "memory");
    {
      float v[6]; float ss = 0.f;
#pragma unroll
      for (int i = 0; i < 6; ++i) { v[i] = lq_[i]; ss += v[i] * v[i]; }
      ss = wave_sum(ss);
      float rstd = rsqrtf(ss * (1.f / 384.f) + EPS);
#pragma unroll
      for (int i = 0; i < 6; ++i) cqn[(size_t)row * 384 + i * 64 + lane] = f2bf(v[i] * rstd * lgq_[i]);
    }
    {
      float4 v = make_float4(__uint_as_float(lkv_[0]), __uint_as_float(lkv_[1]), __uint_as_float(lkv_[2]), __uint_as_float(lkv_[3]));
      float ss = wave_sum(v.x * v.x + v.y * v.y + v.z * v.z + v.w * v.w);
      float rstd = rsqrtf(ss * (1.f / 256.f) + EPS);
      float4 g = make_float4(__uint_as_float(lgkv_[0]), __uint_as_float(lgkv_[1]), __uint_as_float(lgkv_[2]), __uint_as_float(lgkv_[3]));
      float4 o = make_float4(v.x * rstd * g.x, v.y * rstd * g.y, v.z * rstd * g.z, v.w * rstd * g.w);
      if (row < TC) {
        int b = row >> 8, s = row & 255;
        *(float4*)(p.out + OUT_CKV + ((size_t)(b * 2 + l) * 256 + s) * 256 + lane * 4) = o;
      }
      *(uint2*)(ckvn + (size_t)row * 256 + lane * 4) = make_uint2(pack2(o.x, o.y), pack2(o.z, o.w));
    }
    {
      int j = lane & 31;
      float kr = lkr_;
      if (row < TC && lane < 32) {
        int b = row >> 8, s = row & 255;
        p.out[OUT_KR + ((size_t)(b * 2 + l) * 256 + s) * 32 + j] = kr;
      }
      float ss = kr * kr;
#pragma unroll
      for (int o = 16; o > 0; o >>= 1) ss += __shfl_xor(ss, o);
      float val = kr * lg1_;
      float pv = __shfl_xor(val, 8);
      float outv = val;
      if (row >= TC) {
        int half = (j >> 3) & 1;
        float cs = lcs_[0], sn = lcs_[1];
        outv = half == 0 ? val * cs - pv * sn : val * cs + pv * sn;
      }
      if (lane < 32) krr[(size_t)row * 32 + j] = outv;
      if (lane == 0) krss[row] = ss;
    }
  } else {
    int cr = row - T;
    int b = cr >> 9, pp = cr & 511;
    const float* src = p.cache_ckv + ((size_t)(b * 2 + l) * 512 + pp) * 256;
    float4 v = *(const float4*)(src + lane * 4);
    *(uint2*)(ckvn + (size_t)row * 256 + lane * 4) = make_uint2(pack2(v.x, v.y), pack2(v.z, v.w));
    int j = lane & 31;
    float kr = p.cache_krope[((size_t)(b * 2 + l) * 512 + pp) * 32 + j];
    float ss = kr * kr;
#pragma unroll
    for (int o = 16; o > 0; o >>= 1) ss += __shfl_xor(ss, o);
    if (lane < 32) krr[(size_t)row * 32 + j] = kr * g1[64 + j];
    if (lane == 0) krss[row] = ss;
  }
}

DI int hg_entry(int cid, int chunk) { return cid < 256 ? cid * 2 + chunk : 512 + (cid - 256) * 32 + chunk; }

template <bool OUT>
DI void hgrn_chunk(const Params& p, int l, int cid, int chunk, char* smem) {
  const int tid = tid_(), lane = tid & 63, w = tid >> 6;
  int b, hh, dir, L, row0;
  if (cid < 256) { b = cid >> 3; hh = (cid >> 1) & 3; dir = cid & 1; L = 256; row0 = b * 256; }
  else { int c2 = cid - 256; b = c2 >> 3; hh = (c2 >> 1) & 3; dir = c2 & 1; L = 4096; row0 = TC + b * 4096; }
  float* sf = (float*)smem;
  float* sk = sf + 2048;
  float* sq = sk + 2048;
  float* sv = sq + 2048;
  float* so = sv + 2048;
  const u16* ubf = (const u16*)(p.ws + O_UBF);
  float* sloc = (float*)(p.ws + O_SLOC);
  float* dtot = (float*)(p.ws + O_DTOT);
  float S[16];
  if (OUT) {
    if (cid < 256) {
      if (chunk == 0) {
#pragma unroll
        for (int i = 0; i < 16; ++i) S[i] = 0.f;
      } else {
        const float* s = sloc + (size_t)hg_entry(cid, 0) * 4096;
#pragma unroll
        for (int i = 0; i < 16; ++i) S[i] = s[(16 * w + i) * 64 + lane];
      }
    } else {
      const float* s = (const float*)(p.ws + O_SIN) + (size_t)(hg_entry(cid, chunk) - 512) * 4096;
#pragma unroll
      for (int i = 0; i < 16; ++i) S[i] = s[(16 * w + i) * 64 + lane];
    }
  } else {
#pragma unroll
    for (int i = 0; i < 16; ++i) S[i] = 0.f;
  }
  const int kcol = tid & 63;
  float lb = 0.f;
  if (l == 1) {
    float a0 = p.hgrn_lb[(0 * 2 + dir) * 256 + hh * 64 + kcol], a1 = p.hgrn_lb[(1 * 2 + dir) * 256 + hh * 64 + kcol];
    lb = 1.f / (1.f + __expf(a0 - a1));
  }
  float dprod = 1.f;
  unsigned rq[8], rf[8], rv[8];
#define GLOADU16(dst, ptr) asm volatile("global_load_ushort %0, %1, off" : "=v"(dst) : "v"(ptr) : "memory")
#define HG_ISSUE(SC)                                                                  \
  _Pragma("unroll") for (int n = 0; n < 8; ++n) {                                     \
    int i_ = (tid >> 6) + 4 * n;                                                      \
    int tau_ = chunk * 128 + (SC) * 32 + i_;                                          \
    int tpos_ = dir ? (L - 1 - tau_) : tau_;                                          \
    const u16* ur_ = ubf + (size_t)(row0 + tpos_) * 1280 + hh * 64 + kcol;           \
    GLOADU16(rf[n], ur_ + 256 + dir * 256);                                           \
    GLOADU16(rv[n], ur_ + 768);                                                       \
    if (OUT) GLOADU16(rq[n], ur_);                                                    \
  }
  f32x2_t S2[8];
#pragma unroll
  for (int j = 0; j < 8; ++j) S2[j] = (f32x2_t){S[2 * j], S[2 * j + 1]};
  HG_ISSUE(0)
  for (int sc = 0; sc < 4; ++sc) {
    asm volatile("s_waitcnt vmcnt(0)" : "+v"(rf[0]), "+v"(rf[1]), "+v"(rf[2]), "+v"(rf[3]), "+v"(rf[4]), "+v"(rf[5]), "+v"(rf[6]), "+v"(rf[7]),
                 "+v"(rv[0]), "+v"(rv[1]), "+v"(rv[2]), "+v"(rv[3]), "+v"(rv[4]), "+v"(rv[5]), "+v"(rv[6]), "+v"(rv[7]) :: "memory");
    if (OUT) asm volatile("" : "+v"(rq[0]), "+v"(rq[1]), "+v"(rq[2]), "+v"(rq[3]), "+v"(rq[4]), "+v"(rq[5]), "+v"(rq[6]), "+v"(rq[7]) :: "memory");
#pragma unroll
    for (int n = 0; n < 8; ++n) {
      int i = (tid >> 6) + 4 * n;
      float fr = __uint_as_float(rf[n] << 16);
      float e = __expf(-fr);
      float sg = __builtin_amdgcn_rcpf(1.f + e);
      float om = 1.f / (1.f + __expf(fr));
      float f = lb + (1.f - lb) * sg;
      sf[i * 64 + kcol] = f;
      dprod *= f;
      sv[i * 64 + kcol] = __uint_as_float(rv[n] << 16);
      if (OUT) { float q = __uint_as_float(rq[n] << 16); sq[i * 64 + kcol] = q * sigmoidf_(q); }
    }
    if (sc + 1 < 4) { HG_ISSUE(sc + 1) }
    __syncthreads();
    for (int i = 0; i < 32; ++i) {
      const float v = sv[i * 64 + lane];
      const f32x2_t vv = {v, v};
      f32x2_t o2 = {0.f, 0.f};
#pragma unroll
      for (int a = 0; a < 4; ++a) {
        const f32x4 f4 = *(const f32x4*)(sf + i * 64 + 16 * w + 4 * a);
        const f32x2_t fa = {f4[0], f4[1]}, fb = {f4[2], f4[3]};
        S2[2 * a] = __builtin_elementwise_fma(fa, S2[2 * a] - vv, vv);
        S2[2 * a + 1] = __builtin_elementwise_fma(fb, S2[2 * a + 1] - vv, vv);
        if (OUT) {
          const f32x4 q4 = *(const f32x4*)(sq + i * 64 + 16 * w + 4 * a);
          const f32x2_t qa = {q4[0], q4[1]}, qb = {q4[2], q4[3]};
          o2 = __builtin_elementwise_fma(qa, S2[2 * a], o2);
          o2 = __builtin_elementwise_fma(qb, S2[2 * a + 1], o2);
        }
      }
      if (OUT) so[(i * 4 + w) * 64 + lane] = o2[0] + o2[1];
    }
    __syncthreads();
    if (OUT) {
      float* od = (float*)(p.ws + (dir ? O_OB : O_OF));
#pragma unroll
      for (int n = 0; n < 8; ++n) {
        int i = (tid >> 6) + 4 * n;
        int tau = chunk * 128 + sc * 32 + i;
        int tpos = dir ? (L - 1 - tau) : tau;
        float o = so[(i * 4 + 0) * 64 + kcol] + so[(i * 4 + 1) * 64 + kcol] + so[(i * 4 + 2) * 64 + kcol] +
                  so[(i * 4 + 3) * 64 + kcol];
        od[(size_t)(row0 + tpos) * 256 + hh * 64 + kcol] = o;
      }
      __syncthreads();
    }
  }
#pragma unroll
  for (int j = 0; j < 8; ++j) { S[2 * j] = S2[j][0]; S[2 * j + 1] = S2[j][1]; }
  if (!OUT) {
    int e = hg_entry(cid, chunk);
    float* s = sloc + (size_t)e * 4096;
#pragma unroll
    for (int i = 0; i < 16; ++i) s[(16 * w + i) * 64 + lane] = S[i];
    sf[tid] = dprod;
    __syncthreads();
    if (tid < 64) dtot[(size_t)e * 64 + tid] = sf[tid] * sf[64 + tid] * sf[128 + tid] * sf[192 + tid];
    __syncthreads();
  } else if (cid < 256 && chunk == 1) {
    float* s = p.out + OUT_ST + ((size_t)((b * 2 + l) * 2 + dir) * 4 + hh) * 4096;
#pragma unroll
    for (int i = 0; i < 16; ++i) s[(16 * w + i) * 64 + lane] = S[i];
  }
}

template <int R, int NK>
DI void fft_a(const Params& p, int tb, int l2, int k1base, char* smem) {
  const int col = tid_();
  const float2* W = (const float2*)(p.ws + O_TAB) + (R == 16 ? TAB_W16 : TAB_W64);
  const float2* tabL = (const float2*)(p.ws + O_TAB) + (R == 16 ? 80 : 336);
  const float* um = (const float*)(p.ws + O_UM) + (size_t)(tb + l2) * 928 + 672 + col;
  float x[R];
#pragma unroll
  for (int l1 = 0; l1 < R; ++l1) GLOAD4(x[l1], um + (size_t)(R * l1) * 928);
#pragma unroll
  for (int l1 = 0; l1 < R; l1 += 8)
    asm volatile("s_waitcnt vmcnt(0)" : "+v"(x[l1]), "+v"(x[l1 + 1]), "+v"(x[l1 + 2]), "+v"(x[l1 + 3]), "+v"(x[l1 + 4]), "+v"(x[l1 + 5]), "+v"(x[l1 + 6]), "+v"(x[l1 + 7]) :: "memory");
  float2* y = (float2*)(p.ws + O_YFFT);
  float2* sW = (float2*)smem;
  float2* sT = sW + NK * R;
  for (int i = col; i < NK * R; i += 256) sW[i] = W[k1base * R + i];
  if (col < NK) sT[col] = tabL[(k1base + col) * l2];
  __syncthreads();
  for (int k = 0; k < NK; ++k) {
    const int k1 = k1base + k;
    const float2* wr = sW + k * R;
    float yr = 0.f, yi = 0.f;
#pragma unroll
    for (int l1 = 0; l1 < R; ++l1) { float2 w = wr[l1]; yr += x[l1] * w.x; yi -= x[l1] * w.y; if ((l1 & 7) == 7) __builtin_amdgcn_sched_barrier(0); }
    float2 tw = sT[k];
    float re = yr * tw.x + yi * tw.y;
    float im = yi * tw.x - yr * tw.y;
    y[(size_t)(tb + k1 * R + l2) * 256 + col] = make_float2(re, im);
  }
  __syncthreads();
}
DI void fft_a64_sym(const Params& p, int tb, int l2, int k1base, int nkr, char* smem) {
  constexpr int R = 64;
  const int col = tid_();
  const float2* W = (const float2*)(p.ws + O_TAB) + TAB_W64;
  const float2* tabL = (const float2*)(p.ws + O_TAB) + 336;
  const float* um = (const float*)(p.ws + O_UM) + (size_t)(tb + l2) * 928 + 672 + col;
  float x[R];
#pragma unroll
  for (int l1 = 0; l1 < R; ++l1) GLOAD4(x[l1], um + (size_t)(R * l1) * 928);
#pragma unroll
  for (int l1 = 0; l1 < R; l1 += 8)
    asm volatile("s_waitcnt vmcnt(0)" : "+v"(x[l1]), "+v"(x[l1 + 1]), "+v"(x[l1 + 2]), "+v"(x[l1 + 3]), "+v"(x[l1 + 4]), "+v"(x[l1 + 5]), "+v"(x[l1 + 6]), "+v"(x[l1 + 7]) :: "memory");
  float2* y = (float2*)(p.ws + O_YFFT);
  float2* sW = (float2*)smem;
  float2* sT = sW + 17 * R;
  float2* sM = sT + 17;
  for (int i = col; i < nkr * R; i += 256) sW[i] = W[k1base * R + i];
  if (col < nkr) {
    const int k1 = k1base + col;
    sT[col] = tabL[k1 * l2];
    sM[col] = tabL[((64 - k1) & 63) * l2];
  }
  __syncthreads();
  for (int k = 0; k < nkr; ++k) {
    const int k1 = k1base + k;
    const float2* wr = sW + k * R;
    float yr = 0.f, yi = 0.f;
#pragma unroll
    for (int l1 = 0; l1 < R; ++l1) { float2 w = wr[l1]; yr += x[l1] * w.x; yi -= x[l1] * w.y; if ((l1 & 7) == 7) __builtin_amdgcn_sched_barrier(0); }
    const float2 tw = sT[k];
    y[(size_t)(tb + k1 * R + l2) * 256 + col] = make_float2(yr * tw.x + yi * tw.y, yi * tw.x - yr * tw.y);
    if (k1 != 0 && k1 != 32) {
      const float2 tm = sM[k];
      y[(size_t)(tb + (64 - k1) * R + l2) * 256 + col] = make_float2(yr * tm.x - yi * tm.y, -yi * tm.x - yr * tm.y);
    }
  }
  __syncthreads();
}
template <int R, int NK>
DI void fft_c(const Params& p, int tb, int k1, int k2base, char* smem) {
  const int col = tid_();
  const float2* W = (const float2*)(p.ws + O_TAB) + (R == 16 ? TAB_W16 : TAB_W64);
  const float2* y = (const float2*)(p.ws + O_YFFT) + (size_t)(tb + k1 * R) * 256 + col;
  f32x2_t v[R];
#pragma unroll
  for (int l2 = 0; l2 < R; ++l2) GLOAD8(v[l2], y + (size_t)l2 * 256);
#pragma unroll
  for (int l2 = 0; l2 < R; l2 += 8)
    asm volatile("s_waitcnt vmcnt(0)" : "+v"(v[l2]), "+v"(v[l2 + 1]), "+v"(v[l2 + 2]), "+v"(v[l2 + 3]), "+v"(v[l2 + 4]), "+v"(v[l2 + 5]), "+v"(v[l2 + 6]), "+v"(v[l2 + 7]) :: "memory");
  u16* xb = (u16*)(p.ws + O_XBUF);
  const int g = col >> 6, cc = col & 63;
  float2* sW = (float2*)smem;
  for (int i = col; i < NK * R; i += 256) sW[i] = W[k2base * R + i];
  __syncthreads();
  for (int k = 0; k < NK; ++k) {
    const int k2 = k2base + k;
    const float2* wr = sW + k * R;
    float xr = 0.f, xi = 0.f;
#pragma unroll
    for (int l2 = 0; l2 < R; ++l2) {
      float2 w = wr[l2];
      xr += v[l2][0] * w.x + v[l2][1] * w.y;
      xi += v[l2][1] * w.x - v[l2][0] * w.y;
      if ((l2 & 7) == 7) __builtin_amdgcn_sched_barrier(0);
    }
    int row = tb + k1 + R * k2;
    xb[(size_t)row * 512 + g * 128 + cc] = f2bf(xr);
    xb[(size_t)row * 512 + g * 128 + 64 + cc] = f2bf(xi);
  }
  __syncthreads();
}

constexpr int N6_HA = 16 * 31 + 256, N6_FA = 256 + 512, N6_MP = TK / 4;
DI void phase6(const Params& p, int l, char* smem) {
  for (int it = bid_(); it < N6_HA + N6_FA + N6_MP; it += gridDim.x) {
    int t = it;
    if (t < N6_HA) {
      int cid, chunk;
      if (t < 496) { cid = 256 + t / 31; chunk = t % 31; } else { cid = t - 496; chunk = 0; }
      hgrn_chunk<false>(p, l, cid, chunk, smem);
      continue;
    }
    t -= N6_HA;
    if (t < N6_FA) {
      if (t < 256) { int b = t >> 7, r = t & 127; fft_a64_sym(p, TC + b * 4096, r >> 1, (r & 1) ? 17 : 0, (r & 1) ? 16 : 17, smem); }
      else { int u = t - 256; fft_a<16, 16>(p, (u >> 4) * 256, u & 15, 0, smem); }
      continue;
    }
    t -= N6_FA;
    mixprep_rows(p, l, t);
  }
}

DI void hgrn_prefix(const Params& p, int l, int c2, int eb) {
  const int tid = tid_();
  const int e = eb * 256 + tid, k = e >> 6;
  const int b = c2 >> 3, hh = (c2 >> 1) & 3, dir = c2 & 1;
  const float* sloc = (const float*)(p.ws + O_SLOC) + (size_t)(512 + c2 * 32) * 4096 + e;
  const float* dtot = (const float*)(p.ws + O_DTOT) + (size_t)(512 + c2 * 32) * 64 + k;
  float* sin = (float*)(p.ws + O_SIN) + (size_t)(c2 * 32) * 4096 + e;
  float sl[32], dd[32];
  sl[31] = 0.f; dd[31] = 0.f;
#pragma unroll
  for (int j = 0; j < 31; ++j) { GLOAD4(sl[j], sloc + (size_t)j * 4096); GLOAD4(dd[j], dtot + (size_t)j * 64); }
  float S = p.state_hgrn[((size_t)((b * 2 + l) * 2 + dir) * 4 + hh) * 4096 + e];
#pragma unroll
  for (int j = 0; j < 32; j += 8)
    asm volatile("s_waitcnt vmcnt(0)" : "+v"(sl[j]), "+v"(sl[j + 1]), "+v"(sl[j + 2]), "+v"(sl[j + 3]), "+v"(sl[j + 4]), "+v"(sl[j + 5]), "+v"(sl[j + 6]), "+v"(sl[j + 7]),
                 "+v"(dd[j]), "+v"(dd[j + 1]), "+v"(dd[j + 2]), "+v"(dd[j + 3]), "+v"(dd[j + 4]), "+v"(dd[j + 5]), "+v"(dd[j + 6]), "+v"(dd[j + 7]) :: "memory");
  sin[0] = S;
#pragma unroll
  for (int j = 0; j < 31; ++j) { S = dd[j] * S + sl[j]; sin[(size_t)(j + 1) * 4096] = S; }
}

constexpr int N7_Q = 128 * 6, N7_KV = (TK / 128) * 8, N7_FC = 256 + 512, N7_HB = 256;
DI void phase7(const Params& p, int l, char* smem) {
  u16* qraw = (u16*)(p.ws + O_H);
  const u16* cqn = (const u16*)(p.ws + O_CQN);
  const u16* ckvn = (const u16*)(p.ws + O_CKVN);
  const u16* wq = (const u16*)(p.ws + O_WQ) + (size_t)l * 768 * 384;
  const u16* wkv = (const u16*)(p.ws + O_WKV) + (size_t)l * 1024 * 256;
  const float* krr = (const float*)(p.ws + O_KRR);
  const float* krss = (const float*)(p.ws + O_KRSS);
  const float* g1 = p.mla_qk_norm_g + (size_t)(l * 2 + 1) * 96;
  u16* kbuf = (u16*)(p.ws + O_KBUF);
  u16* vt = (u16*)(p.ws + O_VT);
  auto epi_q = [&](f32x4 (&acc)[4][4], int mb, int nb, int lane) {
    const int l15 = lane & 15, quad = lane >> 4;
#pragma unroll
    for (int ni = 0; ni < 4; ++ni)
#pragma unroll
      for (int mi = 0; mi < 4; ++mi)
#pragma unroll
        for (int j = 0; j < 4; ++j) {
          int row = mb + mi * 16 + quad * 4 + j;
          qraw[(size_t)row * 768 + nb + ni * 16 + l15] = f2bf(acc[mi][ni][j]);
        }
  };
  auto epi_kv = [&](f32x4 (&acc)[4][4], int mb, int nb, int lane) {
    const int l15 = lane & 15, quad = lane >> 4;
    const int hd = nb >> 7, isv = (nb >> 6) & 1;
#pragma unroll
    for (int mi = 0; mi < 4; ++mi) {
      int r0 = mb + mi * 16 + quad * 4;
      size_t kb_base, vt_base; int key0, Lk;
      if (r0 < TC) { int b = r0 >> 8; key0 = r0 & 255; Lk = 256; kb_base = (size_t)(b * 8 + hd) * 256 * 96; vt_base = (size_t)(b * 8 + hd) * 64 * 256; }
      else {
        int b;
        if (r0 < T) { b = (r0 - TC) >> 12; key0 = 512 + ((r0 - TC) & 4095); }
        else { b = (r0 - T) >> 9; key0 = (r0 - T) & 511; }
        Lk = 4608;
        kb_base = (size_t)TC * 8 * 96 + (size_t)(b * 8 + hd) * 4608 * 96;
        vt_base = (size_t)TC * 8 * 64 + (size_t)(b * 8 + hd) * 64 * 4608;
      }
      if (!isv) {
        float kss[4]; f32x2_t kr2v[4];
#pragma unroll
        for (int j = 0; j < 4; ++j) { GLOAD4(kss[j], krss + (r0 + j)); GLOAD8(kr2v[j], krr + (size_t)(r0 + j) * 32 + l15 * 2); }
        asm volatile("s_waitcnt vmcnt(0)" : "+v"(kss[0]), "+v"(kss[1]), "+v"(kss[2]), "+v"(kss[3]), "+v"(kr2v[0]), "+v"(kr2v[1]), "+v"(kr2v[2]), "+v"(kr2v[3]) :: "memory");
#pragma unroll
        for (int j = 0; j < 4; ++j) {
          float ss = 0.f;
#pragma unroll
          for (int ni = 0; ni < 4; ++ni) ss += acc[mi][ni][j] * acc[mi][ni][j];
          ss += __shfl_xor(ss, 1); ss += __shfl_xor(ss, 2); ss += __shfl_xor(ss, 4); ss += __shfl_xor(ss, 8);
          int row = r0 + j;
          float rstd = rsqrtf((ss + kss[j]) * (1.f / 96.f) + EPS);
          u16* kd = kbuf + kb_base + (size_t)(key0 + j) * 96;
#pragma unroll
          for (int ni = 0; ni < 4; ++ni) kd[ni * 16 + l15] = f2bf(acc[mi][ni][j] * rstd * g1[ni * 16 + l15]);
          *(unsigned*)(kd + 64 + l15 * 2) = pack2(kr2v[j][0] * rstd, kr2v[j][1] * rstd);
        }
      } else {
#pragma unroll
        for (int ni = 0; ni < 4; ++ni) {
          int d = ni * 16 + l15;
          *(uint2*)(vt + vt_base + (size_t)d * Lk + key0) =
              make_uint2(pack2(acc[mi][ni][0], acc[mi][ni][1]), pack2(acc[mi][ni][2], acc[mi][ni][3]));
        }
      }
    }
  };
  for (int it = bid_(); it < N7_KV + N7_Q + N7_FC + N7_HB; it += gridDim.x) {
    int t = it;
    if (t < N7_KV) { gemm_tile(ckvn, 256, wkv, 256, 256, (t >> 3) * 128, (t & 7) * 128, smem, epi_kv); continue; }
    t -= N7_KV;
    if (t < N7_Q) { gemm_tile(cqn, 384, wq, 384, 384, (t / 6) * 128, (t % 6) * 128, smem, epi_q); continue; }
    t -= N7_Q;
    if (t < N7_FC) {
      if (t < 256) { int b = t >> 7, r = t & 127; fft_c<64, 32>(p, TC + b * 4096, r >> 1, (r & 1) * 32, smem); }
      else { int u = t - 256; fft_c<16, 16>(p, (u >> 4) * 256, u & 15, 0, smem); }
      continue;
    }
    t -= N7_FC;
    hgrn_prefix(p, l, t >> 4, t & 15);
  }
}

DI int kappa(int r) { return (r & ~12) | ((r & 8) >> 1) | ((r & 4) << 1); }

DI void attn_item(const Params& p, int l, bool lat, int b, int hd, int qt, char* smem) {
  const int tid = tid_(), lane = tid & 63, w = tid >> 6;
  const int r = lane & 31, hh = lane >> 5;
  const int Lk = lat ? 4608 : 256;
  const u16* kb = (const u16*)(p.ws + O_KBUF) + (lat ? (size_t)TC * 8 * 96 + (size_t)(b * 8 + hd) * 4608 * 96 : (size_t)(b * 8 + hd) * 256 * 96);
  const u16* vtb = (const u16*)(p.ws + O_VT) + (lat ? (size_t)TC * 8 * 64 + (size_t)(b * 8 + hd) * 64 * 4608 : (size_t)(b * 8 + hd) * 64 * 256);
  const int qrow = (lat ? TC + b * 4096 : b * 256) + qt * 128 + w * 32 + r;
  bf16x8 qf[6];
  {
    const u16* qp = (const u16*)(p.ws + O_H) + (size_t)qrow * 768 + hd * 96;
    const float* g0 = p.mla_qk_norm_g + (size_t)(l * 2) * 96;
    uint4 raw[6];
    float ss = 0.f;
#pragma unroll
    for (int s = 0; s < 6; ++s) {
      raw[s] = *(const uint4*)(qp + 16 * s + 8 * hh);
      unsigned uu[4] = {raw[s].x, raw[s].y, raw[s].z, raw[s].w};
#pragma unroll
      for (int j = 0; j < 4; ++j) {
        float a = __uint_as_float(uu[j] << 16), c = __uint_as_float(uu[j] & 0xffff0000u);
        ss += a * a + c * c;
      }
    }
    ss += __shfl_xor(ss, 32);
    const float rstd = rsqrtf(ss * (1.f / 96.f) + EPS);
    const float qs = 0.10206207261596577f * 1.4426950408889634f;
    const int tpos = (qrow - TC) & 4095;
    const float2* rtab = (const float2*)(p.ws + O_TAB) + 4432;
#pragma unroll
    for (int s = 0; s < 6; ++s) {
      unsigned uu[4] = {raw[s].x, raw[s].y, raw[s].z, raw[s].w};
      float qv[8];
#pragma unroll
      for (int j = 0; j < 4; ++j) {
        qv[2 * j] = __uint_as_float(uu[j] << 16) * rstd * g0[16 * s + 8 * hh + 2 * j];
        qv[2 * j + 1] = __uint_as_float(uu[j] & 0xffff0000u) * rstd * g0[16 * s + 8 * hh + 2 * j + 1];
      }
      if (s >= 4 && lat) {
        int pos = s == 4 ? (tpos >> 6) : (tpos & 63);
#pragma unroll
        for (int j = 0; j < 8; ++j) {
          float val = qv[j];
          float pv = __shfl_xor(val, 32);
          float2 cs2 = rtab[pos * 8 + j];
          qv[j] = hh == 0 ? val * cs2.x - pv * cs2.y : val * cs2.x + pv * cs2.y;
        }
      }
      unsigned pk[4];
#pragma unroll
      for (int j = 0; j < 4; ++j) pk[j] = pack2(qv[2 * j] * qs, qv[2 * j + 1] * qs);
      uint4 u4 = make_uint4(pk[0], pk[1], pk[2], pk[3]);
      qf[s] = *(bf16x8*)&u4;
    }
  }
  f32x16 o0, o1;
#pragma unroll
  for (int i = 0; i < 16; ++i) { o0[i] = 0.f; o1[i] = 0.f; }
  float lsum = 0.f;
  float mfix;
  {
    const float* gq = p.mla_qk_norm_g + (size_t)(l * 2) * 96;
    float mq = 0.f, mk = 0.f;
    for (int e = 0; e < 96; ++e) { mq = fmaxf(mq, fabsf(gq[e])); mk = fmaxf(mk, fabsf(gq[96 + e])); }
    mfix = fminf(9.797958971132712f * 1.4426950408889634f * mq * mk, 100.f);
  }
  constexpr int KST = 64 * 208, VST = 64 * 144, STG = KST + VST;
  u32x4 a0, a1, a2, a3, a4, b0, b1, b2, b3, b4;
  const u16* kg = kb + tid * 8;
  const u16* vg = vtb + (size_t)(tid >> 3) * Lk + (tid & 7) * 8;
  const int ksoff0 = (tid / 12) * 208 + (tid % 12) * 16;
  const int ksoff1 = ((tid + 256) / 12) * 208 + ((tid + 256) % 12) * 16;
  const int ksoff2 = ((tid + 512) / 12) * 208 + ((tid + 512) % 12) * 16;
  const int vsoff = KST + (tid >> 3) * 144 + (tid & 7) * 16;
  const int nkt = Lk >> 6;
  const unsigned lds0a = (unsigned)(size_t)smem;
#define ATT_GLOAD_S(S, KT)                                               \
  {                                                                      \
    const int kt_ = (KT) < nkt ? (KT) : nkt - 1;                         \
    GLOAD16(S##0, kg + (size_t)kt_ * 6144);                              \
    GLOAD16(S##1, kg + (size_t)kt_ * 6144 + 2048);                       \
    GLOAD16(S##2, kg + (size_t)kt_ * 6144 + 4096);                       \
    GLOAD16(S##3, vg + kt_ * 64);                                        \
    GLOAD16(S##4, vg + (size_t)32 * Lk + kt_ * 64);                      \
  }
#define ATT_SSTORE_S(S, BUF)                                             \
  {                                                                      \
    char* base_ = smem + (BUF) * STG;                                    \
    asm volatile("s_waitcnt vmcnt(5)" : "+v"(S##0), "+v"(S##1), "+v"(S##2), "+v"(S##3), "+v"(S##4) :: "memory"); \
    *(u32x4*)(base_ + ksoff0) = S##0;                                    \
    *(u32x4*)(base_ + ksoff1) = S##1;                                    \
    *(u32x4*)(base_ + ksoff2) = S##2;                                    \
    *(u32x4*)(base_ + vsoff) = S##3;                                     \
    *(u32x4*)(base_ + vsoff + 32 * 144) = S##4;                          \
  }
  const int kr_ = kappa(r);
  auto att_compute = [&](const int bsel) {
    const unsigned kaddr = lds0a + bsel * STG + kr_ * 208 + hh * 16;
    const unsigned vaddr = lds0a + bsel * STG + KST + r * 144 + hh * 16;
    bf16x8 ka[6], kc[6];
    DSR(ka[0], kaddr, 0);    DSR(kc[0], kaddr, 6656);
    DSR(ka[1], kaddr, 32);   DSR(kc[1], kaddr, 6688);
    DSR(ka[2], kaddr, 64);   DSR(kc[2], kaddr, 6720);
    DSR(ka[3], kaddr, 96);   DSR(kc[3], kaddr, 6752);
    DSR(ka[4], kaddr, 128);  DSR(kc[4], kaddr, 6784);
    DSR(ka[5], kaddr, 160);  DSR(kc[5], kaddr, 6816);
    f32x16 s0, s1;
#pragma unroll
    for (int i = 0; i < 16; ++i) { s0[i] = -mfix; s1[i] = -mfix; }
#define ATT_W2(N, X, Y) asm volatile("s_waitcnt lgkmcnt(" #N ")" : "+v"(X), "+v"(Y) :: "memory")
    ATT_W2(10, ka[0], kc[0]);
    s0 = __builtin_amdgcn_mfma_f32_32x32x16_bf16(ka[0], qf[0], s0, 0, 0, 0);
    s1 = __builtin_amdgcn_mfma_f32_32x32x16_bf16(kc[0], qf[0], s1, 0, 0, 0);
    ATT_W2(8, ka[1], kc[1]);
    s0 = __builtin_amdgcn_mfma_f32_32x32x16_bf16(ka[1], qf[1], s0, 0, 0, 0);
    s1 = __builtin_amdgcn_mfma_f32_32x32x16_bf16(kc[1], qf[1], s1, 0, 0, 0);
    ATT_W2(6, ka[2], kc[2]);
    s0 = __builtin_amdgcn_mfma_f32_32x32x16_bf16(ka[2], qf[2], s0, 0, 0, 0);
    s1 = __builtin_amdgcn_mfma_f32_32x32x16_bf16(kc[2], qf[2], s1, 0, 0, 0);
    ATT_W2(4, ka[3], kc[3]);
    s0 = __builtin_amdgcn_mfma_f32_32x32x16_bf16(ka[3], qf[3], s0, 0, 0, 0);
    s1 = __builtin_amdgcn_mfma_f32_32x32x16_bf16(kc[3], qf[3], s1, 0, 0, 0);
    ATT_W2(2, ka[4], kc[4]);
    s0 = __builtin_amdgcn_mfma_f32_32x32x16_bf16(ka[4], qf[4], s0, 0, 0, 0);
    s1 = __builtin_amdgcn_mfma_f32_32x32x16_bf16(kc[4], qf[4], s1, 0, 0, 0);
    ATT_W2(0, ka[5], kc[5]);
    s0 = __builtin_amdgcn_mfma_f32_32x32x16_bf16(ka[5], qf[5], s0, 0, 0, 0);
    s1 = __builtin_amdgcn_mfma_f32_32x32x16_bf16(kc[5], qf[5], s1, 0, 0, 0);
    __builtin_amdgcn_sched_barrier(0);
    bf16x8 va[4], vc[4];
    DSR(va[0], vaddr, 0);   DSR(vc[0], vaddr, 4608);
    DSR(va[1], vaddr, 32);  DSR(vc[1], vaddr, 4640);
    DSR(va[2], vaddr, 64);  DSR(vc[2], vaddr, 4672);
    DSR(va[3], vaddr, 96);  DSR(vc[3], vaddr, 4704);
#pragma unroll
    for (int i = 0; i < 16; ++i) { s0[i] = __builtin_amdgcn_exp2f(s0[i]); lsum += s0[i]; s1[i] = __builtin_amdgcn_exp2f(s1[i]); lsum += s1[i]; }
    bf16x8 pb[4];
#pragma unroll
    for (int kbk = 0; kbk < 2; ++kbk)
#pragma unroll
      for (int t2 = 0; t2 < 2; ++t2) {
        unsigned pk[4];
#pragma unroll
        for (int j = 0; j < 4; ++j) {
          float x0 = kbk ? s1[8 * t2 + 2 * j] : s0[8 * t2 + 2 * j];
          float x1 = kbk ? s1[8 * t2 + 2 * j + 1] : s0[8 * t2 + 2 * j + 1];
          pk[j] = pack2(x0, x1);
        }
        uint4 u4 = make_uint4(pk[0], pk[1], pk[2], pk[3]);
        pb[kbk * 2 + t2] = *(bf16x8*)&u4;
      }
    ATT_W2(6, va[0], vc[0]);
    o0 = __builtin_amdgcn_mfma_f32_32x32x16_bf16(va[0], pb[0], o0, 0, 0, 0);
    o1 = __builtin_amdgcn_mfma_f32_32x32x16_bf16(vc[0], pb[0], o1, 0, 0, 0);
    ATT_W2(4, va[1], vc[1]);
    o0 = __builtin_amdgcn_mfma_f32_32x32x16_bf16(va[1], pb[1], o0, 0, 0, 0);
    o1 = __builtin_amdgcn_mfma_f32_32x32x16_bf16(vc[1], pb[1], o1, 0, 0, 0);
    ATT_W2(2, va[2], vc[2]);
    o0 = __builtin_amdgcn_mfma_f32_32x32x16_bf16(va[2], pb[2], o0, 0, 0, 0);
    o1 = __builtin_amdgcn_mfma_f32_32x32x16_bf16(vc[2], pb[2], o1, 0, 0, 0);
    ATT_W2(0, va[3], vc[3]);
    o0 = __builtin_amdgcn_mfma_f32_32x32x16_bf16(va[3], pb[3], o0, 0, 0, 0);
    o1 = __builtin_amdgcn_mfma_f32_32x32x16_bf16(vc[3], pb[3], o1, 0, 0, 0);
    __builtin_amdgcn_sched_barrier(0);
  };
  ATT_GLOAD_S(a, 0)
  ATT_GLOAD_S(b, 1)
  ATT_SSTORE_S(a, 0)
  __syncthreads();
  for (int kt = 0; kt < nkt; kt += 2) {
    ATT_GLOAD_S(a, kt + 2)
    att_compute(0);
    ATT_SSTORE_S(b, 1)
    __syncthreads();
    ATT_GLOAD_S(b, kt + 3)
    att_compute(1);
    ATT_SSTORE_S(a, 0)
    __syncthreads();
  }
  asm volatile("s_waitcnt vmcnt(0)" : "+v"(a0), "+v"(a1), "+v"(a2), "+v"(a3), "+v"(a4), "+v"(b0), "+v"(b1), "+v"(b2), "+v"(b3), "+v"(b4) :: "memory");
  lsum += __shfl_xor(lsum, 32);
  float inv = 1.f / lsum;
  u16* om = (u16*)(p.ws + O_OMLA) + (size_t)qrow * 512 + hd * 64;
#pragma unroll
  for (int gq = 0; gq < 4; ++gq) {
    int d = 8 * gq + 4 * hh;
    *(uint2*)(om + d) = make_uint2(pack2(o0[4 * gq] * inv, o0[4 * gq + 1] * inv), pack2(o0[4 * gq + 2] * inv, o0[4 * gq + 3] * inv));
    *(uint2*)(om + 32 + d) = make_uint2(pack2(o1[4 * gq] * inv, o1[4 * gq + 1] * inv), pack2(o1[4 * gq + 2] * inv, o1[4 * gq + 3] * inv));
  }
}

constexpr int N8_AL = 512, N8_AC = 512, N8_HC = 1024, N8_F2 = 256;
DI void phase8(const Params& p, int l, char* smem) {
  const u16* xb = (const u16*)(p.ws + O_XBUF);
  const u16* wf = (const u16*)(p.ws + O_WF) + (size_t)l * 256 * 512;
  u16* ofn = (u16*)(p.ws + O_OFN);
  auto epi_f = [&](f32x4 (&acc)[4][4], int mb, int nb, int lane) {
    const int l15 = lane & 15, quad = lane >> 4;
    const float sc = mb < TC ? (1.f / 128.f) : (1.f / 512.f);
#pragma unroll
    for (int ni = 0; ni < 4; ++ni)
#pragma unroll
      for (int mi = 0; mi < 4; ++mi)
#pragma unroll
        for (int j = 0; j < 4; ++j) {
          int row = mb + mi * 16 + quad * 4 + j;
          ofn[(size_t)row * 256 + nb + ni * 16 + l15] = f2bf(acc[mi][ni][j] * sc);
        }
  };
  for (int it = bid_(); it < N8_AL + N8_AC + N8_HC + N8_F2; it += gridDim.x) {
    int t = it;
    if (t < N8_AL + N8_AC) {
      bool lat = t < N8_AL;
      int b, hd, qt;
      if (lat) {
        int x = t & 7, y = t >> 3;
        int bh = x * 2 + (y >> 5);
        qt = y & 31; b = bh >> 3; hd = bh & 7;
      } else {
        int u = t - N8_AL;
        b = u >> 4; hd = (u >> 1) & 7; qt = u & 1;
      }
      attn_item(p, l, lat, b, hd, qt, smem);
      continue;
    }
    t -= N8_AL + N8_AC;
    if (t < N8_HC) {
      int cid, chunk;
      if (t < 512) { cid = 256 + (t >> 5); chunk = t & 31; }
      else { int u = t - 512; cid = u >> 1; chunk = u & 1; }
      hgrn_chunk<true>(p, l, cid, chunk, smem);
      continue;
    }
    t -= N8_HC;
    gemm_tile(xb, 512, wf, 512, 512, (t >> 1) * 128, (t & 1) * 128, smem, epi_f);
  }
}

DI void phase9(const Params& p, int l) {
  const int tid = tid_(), lane = tid & 63, wid = tid >> 6;
  u16* cat = (u16*)(p.ws + O_H);
  const float* of = (const float*)(p.ws + O_OF);
  const float* ob = (const float*)(p.ws + O_OB);
  const u16* ubf = (const u16*)(p.ws + O_UBF);
  const u16* omla = (const u16*)(p.ws + O_OMLA);
  const u16* ofn = (const u16*)(p.ws + O_OFN);
  for (int rb = bid_(); rb < T / 4; rb += gridDim.x) {
    int row = rb * 4 + wid;
    u32x4 la_, lb_, lm_, lgh_, lgm0_, lgm1_, lgf_; f32x2_t lg_, lf_;
    GLOAD16(la_, of + (size_t)row * 256 + lane * 4);
    GLOAD16(lb_, ob + (size_t)row * 256 + lane * 4);
    GLOAD8(lg_, ubf + (size_t)row * 1280 + 1024 + lane * 4);
    GLOAD16(lm_, omla + (size_t)row * 512 + lane * 8);
    GLOAD8(lf_, ofn + (size_t)row * 256 + lane * 4);
    GLOAD16(lgh_, p.hgrn_norm_g + l * 64 + (lane & 15) * 4);
    GLOAD16(lgm0_, p.mla_out_norm_g + l * 512 + lane * 8);
    GLOAD16(lgm1_, p.mla_out_norm_g + l * 512 + lane * 8 + 4);
    GLOAD16(lgf_, p.fnet_norm_g + l * 256 + lane * 4);
    asm volatile("s_waitcnt vmcnt(0)" : "+v"(la_), "+v"(lb_), "+v"(lg_), "+v"(lm_), "+v"(lf_), "+v"(lgh_), "+v"(lgm0_), "+v"(lgm1_), "+v"(lgf_) :: "memory");
    {
      float4 a = make_float4(__uint_as_float(la_[0]), __uint_as_float(la_[1]), __uint_as_float(la_[2]), __uint_as_float(la_[3]));
      float4 b = make_float4(__uint_as_float(lb_[0]), __uint_as_float(lb_[1]), __uint_as_float(lb_[2]), __uint_as_float(lb_[3]));
      float4 o = make_float4(a.x + b.x, a.y + b.y, a.z + b.z, a.w + b.w);
      float ss = o.x * o.x + o.y * o.y + o.z * o.z + o.w * o.w;
      ss += __shfl_xor(ss, 1); ss += __shfl_xor(ss, 2); ss += __shfl_xor(ss, 4); ss += __shfl_xor(ss, 8);
      float rstd = rsqrtf(ss * (1.f / 64.f) + EPS);
      float4 g = make_float4(__uint_as_float(lgh_[0]), __uint_as_float(lgh_[1]), __uint_as_float(lgh_[2]), __uint_as_float(lgh_[3]));
      uint2 gr = make_uint2(__float_as_uint(lg_[0]), __float_as_uint(lg_[1]));
      float g0 = __uint_as_float(gr.x << 16), g1 = __uint_as_float(gr.x & 0xffff0000u);
      float g2 = __uint_as_float(gr.y << 16), g3 = __uint_as_float(gr.y & 0xffff0000u);
      float r0 = o.x * rstd * g.x * (g0 * sigmoidf_(g0));
      float r1 = o.y * rstd * g.y * (g1 * sigmoidf_(g1));
      float r2 = o.z * rstd * g.z * (g2 * sigmoidf_(g2));
      float r3 = o.w * rstd * g.w * (g3 * sigmoidf_(g3));
      *(uint2*)(cat + (size_t)row * DM + lane * 4) = make_uint2(pack2(r0, r1), pack2(r2, r3));
    }
    {
      uint4 raw = make_uint4(lm_[0], lm_[1], lm_[2], lm_[3]);
      unsigned uu[4] = {raw.x, raw.y, raw.z, raw.w};
      float v[8]; float ss = 0.f;
#pragma unroll
      for (int j = 0; j < 4; ++j) { v[2 * j] = __uint_as_float(uu[j] << 16); v[2 * j + 1] = __uint_as_float(uu[j] & 0xffff0000u); }
#pragma unroll
      for (int j = 0; j < 8; ++j) ss += v[j] * v[j];
      ss = wave_sum(ss);
      float rstd = rsqrtf(ss * (1.f / 512.f) + EPS);
      const float g[8] = {__uint_as_float(lgm0_[0]), __uint_as_float(lgm0_[1]), __uint_as_float(lgm0_[2]), __uint_as_float(lgm0_[3]), __uint_as_float(lgm1_[0]), __uint_as_float(lgm1_[1]), __uint_as_float(lgm1_[2]), __uint_as_float(lgm1_[3])};
      unsigned pk[4];
#pragma unroll
      for (int j = 0; j < 4; ++j) pk[j] = pack2(v[2 * j] * rstd * g[2 * j], v[2 * j + 1] * rstd * g[2 * j + 1]);
      *(uint4*)(cat + (size_t)row * DM + 256 + lane * 8) = make_uint4(pk[0], pk[1], pk[2], pk[3]);
    }
    {
      uint2 raw = make_uint2(__float_as_uint(lf_[0]), __float_as_uint(lf_[1]));
      float v0 = __uint_as_float(raw.x << 16), v1 = __uint_as_float(raw.x & 0xffff0000u);
      float v2 = __uint_as_float(raw.y << 16), v3 = __uint_as_float(raw.y & 0xffff0000u);
      float ss = wave_sum(v0 * v0 + v1 * v1 + v2 * v2 + v3 * v3);
      float rstd = rsqrtf(ss * (1.f / 256.f) + EPS);
      float4 g = make_float4(__uint_as_float(lgf_[0]), __uint_as_float(lgf_[1]), __uint_as_float(lgf_[2]), __uint_as_float(lgf_[3]));
      *(uint2*)(cat + (size_t)row * DM + 768 + lane * 4) =
          make_uint2(pack2(v0 * rstd * g.x, v1 * rstd * g.y), pack2(v2 * rstd * g.z, v3 * rstd * g.w));
    }
  }
}


#define XB_TMO      128
#define XB_XCNT(j)  (256  + 64 * (j))
#define XB_XSUB(j)  (1280 + 64 * (j))
#define XB_XGEN(j)  (2304 + 64 * (j))
#define XB_TOP      3328
#define XB_TOPGEN   3392
#define XCD_BAR_WORDS 3456
#define XB_SPIN_CAP (1u << 22)
DI unsigned xb_ld(unsigned* p) { return __hip_atomic_load(p, __ATOMIC_RELAXED, __HIP_MEMORY_SCOPE_AGENT); }
DI unsigned xb_add(unsigned* p, unsigned v) { return __hip_atomic_fetch_add(p, v, __ATOMIC_RELAXED, __HIP_MEMORY_SCOPE_AGENT); }
DI unsigned xb_xcc_id() { return (unsigned)__builtin_amdgcn_s_getreg((3 << 11) | 20) & 0xFu; }
#define XB_SPIN(cond, bar) do { unsigned _sp = 0; while (cond) { __builtin_amdgcn_s_sleep(1); \
    if ((++_sp & 255u) == 0u) { if (xb_ld(&(bar)[XB_TMO])) break; if (_sp > XB_SPIN_CAP) { atomicAdd(&(bar)[XB_TMO], 1u); break; } } } } while (0)
struct XcdBarrier { unsigned* bar; unsigned x, nloc, nx; };
DI void xcd_barrier_complete(unsigned* bar, unsigned x, unsigned& nloc, unsigned& nx) {
  const unsigned G = gridDim.x;
  unsigned sum, cnt, mine, sp = 0u;
  for (;;) {
    sum = 0u; cnt = 0u; mine = 0u;
#pragma unroll
    for (unsigned j = 0; j < 16; ++j) { const unsigned c = xb_ld(&bar[XB_XCNT(j)]); sum += c; cnt += (c > 0u) ? 1u : 0u; mine = (j == x) ? c : mine; }
    if (sum == G) break;
    __builtin_amdgcn_s_sleep(1);
    if ((++sp & 255u) == 0u) { if (xb_ld(&bar[XB_TMO])) break; if (sp > XB_SPIN_CAP) { atomicAdd(&bar[XB_TMO], 1u); break; } }
  }
  nloc = mine > 0u ? mine : 1u; nx = cnt > 0u ? cnt : 1u;
}
DI void xcd_barrier(XcdBarrier& b) {
  asm volatile("s_waitcnt vmcnt(0)" ::: "memory");
  __syncthreads();
  if (threadIdx.x == 0) {
    unsigned* bar = b.bar;
    __builtin_amdgcn_s_waitcnt(0);
    if (b.nloc == 0u) xcd_barrier_complete(bar, b.x, b.nloc, b.nx);
    const unsigned nloc = b.nloc, nx = b.nx;
    const unsigned old = xb_add(&bar[XB_XSUB(b.x)], 1u);
    const unsigned gen = old / nloc;
    if (old + 1u == (gen + 1u) * nloc) {
      __builtin_amdgcn_fence(__ATOMIC_RELEASE, "agent");
      asm volatile("s_waitcnt vmcnt(0)" ::: "memory");
      const unsigned og = xb_add(&bar[XB_TOP], 1u);
      const unsigned tg = og / nx;
      if (og + 1u == (tg + 1u) * nx) xb_add(&bar[XB_TOPGEN], 1u);
      else XB_SPIN(xb_ld(&bar[XB_TOPGEN]) == tg, bar);
      __builtin_amdgcn_fence(__ATOMIC_ACQUIRE, "agent");
      xb_add(&bar[XB_XGEN(b.x)], 1u);
      asm volatile("s_waitcnt vmcnt(0)" ::: "memory");
    } else {
      XB_SPIN(xb_ld(&bar[XB_XGEN(b.x)]) == gen, bar);
      __builtin_amdgcn_fence(__ATOMIC_ACQUIRE, "agent");
      asm volatile("s_waitcnt vmcnt(0)" ::: "memory");
    }
  }
  __syncthreads();
}

constexpr int NPHASE = 1 + 2 * 13;
DI void run_phase(const Params& p, int ph, char* smem, int shint = -1) {
  if (ph == 0) { phase_prep(p, smem); return; }
  int l = (ph - 1) / 13, s = shint >= 0 ? shint : (ph - 1) % 13;
  switch (s) {
    case 0: phase_norm(p, l, 0, l == 0); break;
    case 1: phase_ffn_gu(p, l, 0, smem); break;
    case 2: phase_gemm_resid(p, (const u16*)(p.ws + O_BIG), DFF, (const u16*)(p.ws + O_WDN) + (size_t)(l * 2 + 0) * DM * DFF, l, 2, 0.5f, smem); break;
    case 3: phase_norm(p, l, 1, false); break;
    case 4: phase_win(p, l, smem); break;
    case 5: phase6(p, l, smem); break;
    case 6: phase7(p, l, smem); break;
    case 7: phase8(p, l, smem); break;
    case 8: phase9(p, l); break;
    case 9: phase_gemm_resid(p, (const u16*)(p.ws + O_H), DM, (const u16*)(p.ws + O_WO) + (size_t)l * DM * DM, l, 5, 1.0f, smem); break;
    case 10: phase_norm(p, l, 2, false); break;
    case 11: phase_ffn_gu(p, l, 1, smem); break;
    case 12: phase_gemm_resid(p, (const u16*)(p.ws + O_BIG), DFF, (const u16*)(p.ws + O_WDN) + (size_t)(l * 2 + 1) * DM * DFF, l, 8, 0.5f, smem); break;
  }
}

#if MEGA
__global__ void __launch_bounds__(256, 2) mega_kernel(Params p, int ph0, int ph1) {
  __shared__ __attribute__((aligned(16))) char smem[SMEM_BYTES];
  cg::grid_group grid = cg::this_grid();
  XcdBarrier xb;
  xb.bar = (unsigned*)(p.ws + O_BAR); xb.x = xb_xcc_id(); xb.nloc = 0u; xb.nx = 0u;
  if (ph1 - ph0 > 1 && threadIdx.x == 0) (void)xb_add(&xb.bar[XB_XCNT(xb.x)], 1u);
  for (int ph = ph0; ph < ph1; ++ph) {
    run_phase(p, ph, smem);
#ifdef PROBE_DUP
    if (ph > 0 && ((PROBE_DUP >> ((ph - 1) % 13)) & 1)) { xcd_barrier(xb); run_phase(p, ph, smem); }
#endif
    if (ph + 1 < ph1) { if (p.ws == nullptr) grid.sync(); else xcd_barrier(xb); }
  }
}
#else
template <int S>
__global__ void __launch_bounds__(256, 2) phase_kernel(Params p, int l) {
  __shared__ __attribute__((aligned(16))) char smem[SMEM_BYTES];
  if (S < 0) phase_prep(p, smem); else run_phase(p, 1 + l * 13 + S, smem, S);
}
#endif

extern "C" void kernel_launch(void* const* d_in, const int* in_sizes, int n_in, void* d_out, int out_size, void* d_ws,
                              size_t ws_size, hipStream_t stream) {
  Params p{};
  const float** pp = (const float**)&p;
  for (int i = 0; i < 24; ++i) pp[i] = (const float*)d_in[i];
  p.out = (float*)d_out;
  p.ws = (char*)d_ws;
  if (ws_size < WS_TOTAL) { fprintf(stderr, "workspace too small: %zu < %zu\n", ws_size, (size_t)WS_TOTAL); return; }
#if MEGA
  static int grid_blocks = 0;
  if (!grid_blocks) {
    int dev = 0, cus = 0, per_cu = 0;
    hipGetDevice(&dev);
    hipDeviceGetAttribute(&cus, hipDeviceAttributeMultiprocessorCount, dev);
    hipOccupancyMaxActiveBlocksPerMultiprocessor(&per_cu, mega_kernel, 256, 0);
    (void)per_cu;
    grid_blocks = cus * 2;
  }
  hipMemsetAsync(p.ws + O_BAR, 0, XCD_BAR_WORDS * 4, stream);
#if MEGA == 2
  for (int ph = 0; ph < NPHASE; ++ph) mega_kernel<<<grid_blocks, 256, 0, stream>>>(p, ph, ph + 1);
#else
  int ph0 = 0, ph1 = NPHASE;
  void* args[] = {&p, &ph0, &ph1};
  hipError_t e = hipLaunchCooperativeKernel((void*)mega_kernel, dim3(grid_blocks), dim3(256), args, 0, stream);
  if (e != hipSuccess) fprintf(stderr, "cooperative launch failed: %s (grid %d)\n", hipGetErrorString(e), grid_blocks);
#endif
#else
  phase_kernel<-1><<<512, 256, 0, stream>>>(p, 0);
  for (int l = 0; l < 2; ++l) {
    phase_kernel<0><<<512, 256, 0, stream>>>(p, l);
    phase_kernel<1><<<512, 256, 0, stream>>>(p, l);
    phase_kernel<2><<<512, 256, 0, stream>>>(p, l);
    phase_kernel<3><<<512, 256, 0, stream>>>(p, l);
    phase_kernel<4><<<512, 256, 0, stream>>>(p, l);
    phase_kernel<5><<<512, 256, 0, stream>>>(p, l);
    phase_kernel<6><<<512, 256, 0, stream>>>(p, l);
    phase_kernel<7><<<512, 256, 0, stream>>>(p, l);
    phase_kernel<8><<<512, 256, 0, stream>>>(p, l);
    phase_kernel<9><<<512, 256, 0, stream>>>(p, l);
    phase_kernel<10><<<512, 256, 0, stream>>>(p, l);
    phase_kernel<11><<<512, 256, 0, stream>>>(p, l);
    phase_kernel<12><<<512, 256, 0, stream>>>(p, l);
  }
#endif
}
```

```cpp
#include <hip/hip_runtime.h>
#include <hip/hip_cooperative_groups.h>
#include <stdint.h>
#include <stdio.h>
namespace cg = cooperative_groups;

#ifndef MEGA
#define MEGA 1
#endif

typedef unsigned short u16;
typedef __attribute__((ext_vector_type(8))) short bf16x8;
typedef __attribute__((ext_vector_type(4))) float f32x4;
typedef __attribute__((ext_vector_type(16))) float f32x16;
#define DI __device__ __forceinline__

constexpr int T = 16384, TC = 8192, DM = 1024, DFF = 2816, NGU = 5632, NIN = 2208, NINP = 2304;
constexpr int TK = 17408;
constexpr float EPS = 1e-6f;
constexpr int SMEM_BYTES = 65536;

constexpr size_t al(size_t x) { return (x + 255) & ~(size_t)255; }
constexpr size_t O_WGU = 0;
constexpr size_t O_WDN = O_WGU + al((size_t)4 * NGU * DM * 2);
constexpr size_t O_WIN = O_WDN + al((size_t)4 * DM * DFF * 2);
constexpr size_t O_WQ = O_WIN + al((size_t)2 * NINP * DM * 2);
constexpr size_t O_WKV = O_WQ + al((size_t)2 * 768 * 384 * 2);
constexpr size_t O_WO = O_WKV + al((size_t)2 * 1024 * 256 * 2);
constexpr size_t O_WF = O_WO + al((size_t)2 * 1024 * 1024 * 2);
constexpr size_t O_MOD = O_WF + al((size_t)2 * 256 * 512 * 2);
constexpr size_t O_TAB = O_MOD + al((size_t)2 * 3 * 9216 * 4);
constexpr int TAB_W64 = 4944, TAB_W16 = 4944 + 4096, TAB_N = 4944 + 4096 + 256;
constexpr size_t O_H = O_TAB + al((size_t)TAB_N * 8);
constexpr size_t O_BIG = O_H + al((size_t)T * DM * 2);
constexpr size_t SZ_BIG = al((size_t)T * 1280 * 2) + al((size_t)T * 928 * 4);
constexpr size_t O_UBF = O_BIG;
constexpr size_t O_UM = O_BIG + al((size_t)T * 1280 * 2);
constexpr size_t O_C1 = O_BIG + SZ_BIG;
constexpr size_t O_CQN = O_C1;
constexpr size_t O_CKVN = O_CQN + al((size_t)T * 384 * 2);
constexpr size_t O_YFFT = O_CKVN + al((size_t)TK * 256 * 2);
constexpr size_t E_C1A = O_YFFT + al((size_t)T * 256 * 8);
constexpr size_t O_OMLA = O_C1;
constexpr size_t O_OF = O_OMLA + al((size_t)T * 512 * 2);
constexpr size_t O_OB = O_OF + al((size_t)T * 256 * 4);
constexpr size_t O_OFN = O_OB + al((size_t)T * 256 * 4);
constexpr size_t E_C1B = O_OFN + al((size_t)T * 256 * 2);
constexpr size_t O_C2 = (E_C1A > E_C1B ? E_C1A : E_C1B);
constexpr size_t O_KBUF = O_C2;
constexpr size_t O_VT = O_KBUF + al((size_t)TK * 8 * 96 * 2);
constexpr size_t O_XBUF = O_VT + al((size_t)TK * 8 * 64 * 2);
constexpr size_t O_SLOC = O_XBUF + al((size_t)T * 512 * 2);
constexpr size_t O_DTOT = O_SLOC + al((size_t)1024 * 4096 * 4);
constexpr size_t O_KRR = O_DTOT + al((size_t)1024 * 64 * 4);
constexpr size_t O_KRSS = O_KRR + al((size_t)TK * 32 * 4);
constexpr size_t O_BAR = O_KRSS + al((size_t)TK * 4);
constexpr size_t O_SIN = O_H + (size_t)T * 768 * 2;
static_assert((size_t)T * 768 * 2 + (size_t)512 * 4096 * 4 <= (size_t)T * DM * 2, "sin fits behind qraw");
constexpr size_t WS_TOTAL = O_BAR + al((size_t)3456 * 4);
static_assert(WS_TOTAL <= (size_t)369098752, "workspace too large");
static_assert((size_t)T * DFF * 2 <= SZ_BIG, "act fits");
static_assert((size_t)T * 768 * 2 <= (size_t)T * DM * 2, "qraw fits in h");

constexpr size_t OUT_X = 0;
constexpr size_t OUT_CKV = (size_t)T * DM;
constexpr size_t OUT_KR = OUT_CKV + (size_t)32 * 2 * 256 * 256;
constexpr size_t OUT_ST = OUT_KR + (size_t)32 * 2 * 256 * 32;

struct Params {
  const float *x_prompt, *x_sample, *cache_ckv, *cache_krope, *state_hgrn, *c, *c_ctx, *ada_w, *ada_b, *norm_g;
  const float *ffn_w_gu, *ffn_w_down, *w_in, *hgrn_lb, *hgrn_norm_g, *mla_q_norm_g, *mla_w_q_up, *mla_kv_norm_g;
  const float *mla_w_kv_up, *mla_qk_norm_g, *mla_out_norm_g, *fnet_w, *fnet_norm_g, *w_out;
  float* out;
  char* ws;
};

typedef unsigned u32x4 __attribute__((ext_vector_type(4)));
#define GLOAD16(dst, ptr) asm volatile("global_load_dwordx4 %0, %1, off" : "=v"(dst) : "v"(ptr) : "memory")
#define VMWAIT0() asm volatile("s_waitcnt vmcnt(0)" ::: "memory")
#define GLOAD4(dst, ptr) asm volatile("global_load_dword %0, %1, off" : "=v"(dst) : "v"(ptr) : "memory")
#define GLOAD8(dst, ptr) asm volatile("global_load_dwordx2 %0, %1, off" : "=v"(dst) : "v"(ptr) : "memory")
DI int tid_() { int t = threadIdx.x; asm volatile("" : "+v"(t)); return t; }
DI int bid_() { int t = blockIdx.x; asm volatile("" : "+s"(t)); return t; }
DI u16 f2bf(float x) { __bf16 h = (__bf16)x; return __builtin_bit_cast(u16, h); }
DI float bf2f(u16 h) { return __uint_as_float(((unsigned)h) << 16); }
typedef __bf16 bf16x2_t __attribute__((ext_vector_type(2)));
typedef float f32x2_t __attribute__((ext_vector_type(2)));
DI unsigned pack2(float a, float b) { f32x2_t v = {a, b}; bf16x2_t r = __builtin_convertvector(v, bf16x2_t); return __builtin_bit_cast(unsigned, r); }
DI float wave_sum(float v) {
#pragma unroll
  for (int o = 32; o > 0; o >>= 1) v += __shfl_xor(v, o);
  return v;
}
DI int cond_of(int row) { return row < TC ? 0 : 1 + ((row - TC) >> 12); }
DI float sigmoidf_(float x) { return __builtin_amdgcn_rcpf(1.f + __expf(-x)); }

template <class Epi>
DI void gemm_tile(const u16* __restrict__ A, int lda, const u16* __restrict__ Bt, int ldb, int K, int m0, int n0,
                  char* smem, Epi epi) {
  const int tid = tid_(), lane = tid & 63, wid = tid >> 6, wm = wid >> 1, wn = wid & 1;
  const int l15 = lane & 15, quad = lane >> 4;
  f32x4 acc[4][4];
#pragma unroll
  for (int i = 0; i < 4; ++i)
#pragma unroll
    for (int j = 0; j < 4; ++j) acc[i][j] = (f32x4){0.f, 0.f, 0.f, 0.f};
  const int lrow = tid >> 3;
  const int gch = (tid & 7) ^ ((tid >> 4) & 7);
  const u16* ga = A + (size_t)(m0 + lrow) * lda + gch * 8;
  const u16* gb = Bt + (size_t)(n0 + lrow) * ldb + gch * 8;
  const int nk = K >> 6;
#define GEMM_GLDS(KT, BUF)                                                                                     \
  {                                                                                                            \
    char* d_ = smem + (BUF) * 32768 + tid * 16;                                                                \
    _Pragma("unroll") for (int i = 0; i < 4; ++i) {                                                            \
      __builtin_amdgcn_global_load_lds((const unsigned*)(ga + (size_t)i * 32 * lda + (KT) * 64),               \
                                       (unsigned*)(d_ + i * 4096), 16, 0, 0);                                  \
      __builtin_amdgcn_global_load_lds((const unsigned*)(gb + (size_t)i * 32 * ldb + (KT) * 64),               \
                                       (unsigned*)(d_ + 16384 + i * 4096), 16, 0, 0);                          \
    }                                                                                                          \
  }
  GEMM_GLDS(0, 0)
  asm volatile("s_waitcnt vmcnt(0)" ::: "memory");
  __builtin_amdgcn_s_barrier(); asm volatile("" ::: "memory");
  const unsigned lds0 = (unsigned)(size_t)smem;
  const int sw_ = (l15 >> 1) & 7;
  const unsigned ab0 = lds0 + (wm * 64 + l15) * 128 + ((quad ^ sw_) << 4);
  const unsigned ab1 = lds0 + (wm * 64 + l15) * 128 + (((4 + quad) ^ sw_) << 4);
  const unsigned bb0 = lds0 + 16384 + (wn * 64 + l15) * 128 + ((quad ^ sw_) << 4);
  const unsigned bb1 = lds0 + 16384 + (wn * 64 + l15) * 128 + (((4 + quad) ^ sw_) << 4);
#define DSR(dst, addr, OFF) asm volatile("ds_read_b128 %0, %1 offset:" #OFF : "=v"(dst) : "v"(addr) : "memory")
#define GEMM_MMA(AF, BF)                                                                     \
  _Pragma("unroll") for (int mi = 0; mi < 4; ++mi)                                           \
    _Pragma("unroll") for (int ni = 0; ni < 4; ++ni)                                         \
      acc[mi][ni] = __builtin_amdgcn_mfma_f32_16x16x32_bf16(AF[mi], BF[ni], acc[mi][ni], 0, 0, 0);
#define GEMM_WAIT(N, AF, BF)                                                                 \
  asm volatile("s_waitcnt lgkmcnt(" #N ")" : "+v"(AF[0]), "+v"(AF[1]), "+v"(AF[2]), "+v"(AF[3]), "+v"(BF[0]), "+v"(BF[1]), "+v"(BF[2]), "+v"(BF[3]) :: "memory");
#define GEMM_COMPUTE(O0, O1, O2, O3)                                                         \
  {                                                                                          \
    bf16x8 a0[4], b0[4], a1[4], b1[4];                                                       \
    DSR(a0[0], ab0, O0); DSR(a0[1], ab0, O1); DSR(a0[2], ab0, O2); DSR(a0[3], ab0, O3);      \
    DSR(b0[0], bb0, O0); DSR(b0[1], bb0, O1); DSR(b0[2], bb0, O2); DSR(b0[3], bb0, O3);      \
    DSR(a1[0], ab1, O0); DSR(a1[1], ab1, O1); DSR(a1[2], ab1, O2); DSR(a1[3], ab1, O3);      \
    DSR(b1[0], bb1, O0); DSR(b1[1], bb1, O1); DSR(b1[2], bb1, O2); DSR(b1[3], bb1, O3);      \
    GEMM_WAIT(8, a0, b0)                                                                     \
    __builtin_amdgcn_s_setprio(1);                                                           \
    GEMM_MMA(a0, b0)                                                                         \
    __builtin_amdgcn_sched_barrier(0);                                                       \
    GEMM_WAIT(0, a1, b1)                                                                     \
    GEMM_MMA(a1, b1)                                                                         \
    __builtin_amdgcn_s_setprio(0);                                                           \
    __builtin_amdgcn_sched_barrier(0);                                                       \
  }
  for (int kt = 0; kt < nk; kt += 2) {
    GEMM_GLDS(kt + 1, 1)
    GEMM_COMPUTE(0, 2048, 4096, 6144)
    asm volatile("s_waitcnt vmcnt(0)" ::: "memory");
    __builtin_amdgcn_s_barrier(); asm volatile("" ::: "memory");
    if (kt + 2 < nk) GEMM_GLDS(kt + 2, 0)
    GEMM_COMPUTE(32768, 34816, 36864, 38912)
    asm volatile("s_waitcnt vmcnt(0)" ::: "memory");
    __builtin_amdgcn_s_barrier(); asm volatile("" ::: "memory");
  }
  epi(acc, m0 + wm * 64, n0 + wn * 64, lane);
}

DI void tile_mn(int t, int nM, int nN, int& mt, int& nt) {
  int per = 16 * nN;
  int g = t / per, r = t - g * per;
  int gm = nM - g * 16; if (gm > 16) gm = 16;
  mt = g * 16 + (r % gm);
  nt = r / gm;
}

DI void transpose_tile(const float* __restrict__ src, int K, int N, u16* __restrict__ dst, int kt, int nt, int mode,
                       float* tile) {
  const int tid = tid_();
  const int k0 = kt * 64, n0 = nt * 64;
  {
    const int n = tid & 63;
    const bool inb = n0 + n < N;
    const float* sp = src + (size_t)(k0 + (tid >> 6)) * N + (inb ? n0 + n : 0);
    float tv[16];
#pragma unroll
    for (int i = 0; i < 16; ++i) GLOAD4(tv[i], sp + (size_t)(i * 4) * N);
    asm volatile("s_waitcnt vmcnt(0)" : "+v"(tv[0]), "+v"(tv[1]), "+v"(tv[2]), "+v"(tv[3]), "+v"(tv[4]), "+v"(tv[5]), "+v"(tv[6]), "+v"(tv[7]),
                 "+v"(tv[8]), "+v"(tv[9]), "+v"(tv[10]), "+v"(tv[11]), "+v"(tv[12]), "+v"(tv[13]), "+v"(tv[14]), "+v"(tv[15]) :: "memory");
#pragma unroll
    for (int i = 0; i < 16; ++i) tile[(i * 4 + (tid >> 6)) * 65 + n] = inb ? tv[i] : 0.f;
  }
  __syncthreads();
  const int nl = tid >> 2, ks = (tid & 3) * 16;
  int n = n0 + nl, nd = n;
  if (mode == 1) {
    if (n < DFF) nd = (n >> 4) * 32 + (n & 15);
    else { int c = n - DFF; nd = (c >> 4) * 32 + 16 + (c & 15); }
  }
  unsigned pk[8];
#pragma unroll
  for (int j = 0; j < 8; ++j) pk[j] = pack2(tile[(ks + 2 * j) * 65 + nl], tile[(ks + 2 * j + 1) * 65 + nl]);
  uint4* d = (uint4*)(dst + (size_t)nd * K + k0 + ks);
  d[0] = make_uint4(pk[0], pk[1], pk[2], pk[3]);
  d[1] = make_uint4(pk[4], pk[5], pk[6], pk[7]);
  __syncthreads();
}

constexpr int NT_WGU = 4 * 16 * 88, NT_WDN = 4 * 44 * 16, NT_WIN = 2 * 16 * 36, NT_WQ = 2 * 6 * 12, NT_WKV = 2 * 4 * 16,
              NT_WO = 2 * 16 * 16;
constexpr int NT_TR = NT_WGU + NT_WDN + NT_WIN + NT_WQ + NT_WKV + NT_WO;
constexpr int NT_WF = 1024, NT_MOD = 288, NT_TAB = 1;
constexpr int NT_PREP = NT_TR + NT_WF + NT_MOD + NT_TAB;

DI void phase_prep(const Params& p, char* smem) {
  const int tid = tid_();
  float* fs = (float*)smem;
  for (int it = bid_(); it < NT_PREP; it += gridDim.x) {
    int t = it;
    if (t < NT_TR) {
      if (t < NT_WGU) {
        int m = t / (16 * 88), r = t % (16 * 88);
        transpose_tile(p.ffn_w_gu + (size_t)m * DM * NGU, DM, NGU, (u16*)(p.ws + O_WGU) + (size_t)m * NGU * DM, r / 88,
                       r % 88, 1, fs);
        continue;
      }
      t -= NT_WGU;
      if (t < NT_WDN) {
        int m = t / (44 * 16), r = t % (44 * 16);
        transpose_tile(p.ffn_w_down + (size_t)m * DFF * DM, DFF, DM, (u16*)(p.ws + O_WDN) + (size_t)m * DM * DFF, r / 16,
                       r % 16, 0, fs);
        continue;
      }
      t -= NT_WDN;
      if (t < NT_WIN) {
        int m = t / (16 * 36), r = t % (16 * 36);
        transpose_tile(p.w_in + (size_t)m * DM * NIN, DM, NIN, (u16*)(p.ws + O_WIN) + (size_t)m * NINP * DM, r / 36,
                       r % 36, 0, fs);
        continue;
      }
      t -= NT_WIN;
      if (t < NT_WQ) {
        int m = t / 72, r = t % 72;
        transpose_tile(p.mla_w_q_up + (size_t)m * 384 * 768, 384, 768, (u16*)(p.ws + O_WQ) + (size_t)m * 768 * 384, r / 12,
                       r % 12, 0, fs);
        continue;
      }
      t -= NT_WQ;
      if (t < NT_WKV) {
        int m = t / 64, r = t % 64;
        transpose_tile(p.mla_w_kv_up + (size_t)m * 256 * 1024, 256, 1024, (u16*)(p.ws + O_WKV) + (size_t)m * 1024 * 256,
                       r / 16, r % 16, 0, fs);
        continue;
      }
      t -= NT_WKV;
      {
        int m = t / 256, r = t % 256;
        transpose_tile(p.w_out + (size_t)m * DM * DM, DM, DM, (u16*)(p.ws + O_WO) + (size_t)m * DM * DM, r / 16, r % 16, 0,
                       fs);
        continue;
      }
    }
    t -= NT_TR;
    if (t < NT_WF) {
      int e = t * 256 + tid;
      int l = e >> 17, r = e & 131071;
      int nrow = r >> 9, kcol = r & 511;
      int g = nrow >> 6, d = nrow & 63, g2 = kcol >> 7, part = (kcol >> 6) & 1, c = kcol & 63;
      float v = 0.f;
      if (g == g2) {
        const float* fw = p.fnet_w + ((size_t)(l * 4 + g) * 64) * 64 + d;
        float fv[64];
#pragma unroll
        for (int m = 0; m < 64; ++m) GLOAD4(fv[m], fw + m * 64);
#pragma unroll
        for (int m = 0; m < 64; m += 8)
          asm volatile("s_waitcnt vmcnt(0)" : "+v"(fv[m]), "+v"(fv[m + 1]), "+v"(fv[m + 2]), "+v"(fv[m + 3]), "+v"(fv[m + 4]), "+v"(fv[m + 5]), "+v"(fv[m + 6]), "+v"(fv[m + 7]) :: "memory");
#pragma unroll
        for (int m = 0; m < 64; ++m) {
          int idx = (m * c) & 63;
          float ang = (float)idx * (6.283185307179586f / 64.f);
          float w = part ? __sinf(ang) : __cosf(ang);
          v += w * fv[m];
        }
      }
      ((u16*)(p.ws + O_WF))[e] = f2bf(v);
      continue;
    }
    t -= NT_WF;
    if (t < NT_MOD) {
      int l = t / 144, cb = t % 144;
      float* sc = fs;
      float* red = fs + 3072;
      for (int i = tid; i < 3072; i += 256) {
        int cnd = i >> 10, k = i & 1023;
        float v = cnd == 0 ? p.c_ctx[k] : p.c[(cnd - 1) * 1024 + k];
        sc[i] = v * sigmoidf_(v);
      }
      __syncthreads();
      int kq = tid >> 4, cq = tid & 15;
      float a[3][4];
#pragma unroll
      for (int i = 0; i < 3; ++i)
#pragma unroll
        for (int j = 0; j < 4; ++j) a[i][j] = 0.f;
      const float* wbase = p.ada_w + (size_t)l * 1024 * 9216 + cb * 64 + cq * 4;
      for (int k0 = kq; k0 < 1024; k0 += 128) {
        u32x4 wv[8];
#pragma unroll
        for (int j = 0; j < 8; ++j) GLOAD16(wv[j], wbase + (size_t)(k0 + 16 * j) * 9216);
        asm volatile("s_waitcnt vmcnt(0)" : "+v"(wv[0]), "+v"(wv[1]), "+v"(wv[2]), "+v"(wv[3]), "+v"(wv[4]), "+v"(wv[5]), "+v"(wv[6]), "+v"(wv[7]) :: "memory");
#pragma unroll
        for (int j = 0; j < 8; ++j) {
          const int k = k0 + 16 * j;
          const float wx = __uint_as_float(wv[j][0]), wy = __uint_as_float(wv[j][1]), wz = __uint_as_float(wv[j][2]), ww = __uint_as_float(wv[j][3]);
#pragma unroll
          for (int i = 0; i < 3; ++i) {
            float s = sc[i * 1024 + k];
            a[i][0] += s * wx; a[i][1] += s * wy; a[i][2] += s * wz; a[i][3] += s * ww;
          }
        }
      }
#pragma unroll
      for (int i = 0; i < 3; ++i)
#pragma unroll
        for (int j = 0; j < 4; ++j) red[(kq * 3 + i) * 64 + cq * 4 + j] = a[i][j];
      __syncthreads();
      if (tid < 192) {
        int i = tid >> 6, col = tid & 63;
        float s = 0.f;
        for (int q = 0; q < 16; ++q) s += red[(q * 3 + i) * 64 + col];
        int cc = cb * 64 + col;
        ((float*)(p.ws + O_MOD))[(size_t)(l * 3 + i) * 9216 + cc] = s + p.ada_b[l * 9216 + cc];
      }
      __syncthreads();
      continue;
    }
    t -= NT_MOD;
    {
      float2* tab = (float2*)(p.ws + O_TAB);
      for (int i = tid; i < TAB_N; i += 256) {
        int n, L;
        float ang;
        if (i < 4432) {
          if (i < 16) { n = i; L = 16; }
          else if (i < 80) { n = i - 16; L = 64; }
          else if (i < 336) { n = i - 80; L = 256; }
          else { n = i - 336; L = 4096; }
          ang = (float)n * (6.283185307179586f / (float)L);
        } else if (i < TAB_W64) {
          int e = i - 4432;
          float freq = exp2f(-(float)(e & 7) * (13.287712379549449f / 8.f));
          ang = (float)(e >> 3) * freq;
        } else if (i < TAB_W16) {
          int e = i - TAB_W64;
          ang = (float)(((e >> 6) * (e & 63)) & 63) * (6.283185307179586f / 64.f);
        } else {
          int e = i - TAB_W16;
          ang = (float)(((e >> 4) * (e & 15)) & 15) * (6.283185307179586f / 16.f);
        }
        tab[i] = make_float2(cosf(ang), sinf(ang));
      }
    }
  }
}

DI void phase_norm(const Params& p, int l, int idx, bool first) {
  const int tid = tid_(), lane = tid & 63, wid = tid >> 6;
  const float* mod = (const float*)(p.ws + O_MOD) + (size_t)l * 3 * 9216;
  const float* g = p.norm_g + (size_t)(l * 3 + idx) * 1024;
  u16* h = (u16*)(p.ws + O_H);
  for (int rb = bid_(); rb < T / 8; rb += gridDim.x) {
    float4 v[2][4];
    float ss[2];
#pragma unroll
    for (int q = 0; q < 2; ++q) {
      const int row = rb * 8 + q * 4 + wid;
      const float* src = first ? (row < TC ? p.x_prompt + (size_t)row * DM : p.x_sample + (size_t)(row - TC) * DM)
                               : p.out + (size_t)row * DM;
#pragma unroll
      for (int i = 0; i < 4; ++i) v[q][i] = *(const float4*)(src + i * 256 + lane * 4);
    }
#pragma unroll
    for (int q = 0; q < 2; ++q) {
      float s = 0.f;
#pragma unroll
      for (int i = 0; i < 4; ++i) s += v[q][i].x * v[q][i].x + v[q][i].y * v[q][i].y + v[q][i].z * v[q][i].z + v[q][i].w * v[q][i].w;
      ss[q] = s;
    }
#pragma unroll
    for (int o = 32; o > 0; o >>= 1) { ss[0] += __shfl_xor(ss[0], o); ss[1] += __shfl_xor(ss[1], o); }
    u32x4 pg[4], psc[2][4], psh[2][4];
#pragma unroll
    for (int i = 0; i < 4; ++i) GLOAD16(pg[i], g + i * 256 + lane * 4);
#pragma unroll
    for (int q = 0; q < 2; ++q) {
      const int row = rb * 8 + q * 4 + wid;
      const float* mc = mod + (size_t)cond_of(row) * 9216;
#pragma unroll
      for (int i = 0; i < 4; ++i) {
        GLOAD16(psc[q][i], mc + (3 * idx + 1) * 1024 + i * 256 + lane * 4);
        GLOAD16(psh[q][i], mc + (3 * idx) * 1024 + i * 256 + lane * 4);
      }
    }
    asm volatile("s_waitcnt vmcnt(0)" : "+v"(pg[0]), "+v"(pg[1]), "+v"(pg[2]), "+v"(pg[3]) :: "memory");
    asm volatile("" : "+v"(psc[0][0]), "+v"(psc[0][1]), "+v"(psc[0][2]), "+v"(psc[0][3]), "+v"(psc[1][0]), "+v"(psc[1][1]), "+v"(psc[1][2]), "+v"(psc[1][3]) :: "memory");
    asm volatile("" : "+v"(psh[0][0]), "+v"(psh[0][1]), "+v"(psh[0][2]), "+v"(psh[0][3]), "+v"(psh[1][0]), "+v"(psh[1][1]), "+v"(psh[1][2]), "+v"(psh[1][3]) :: "memory");
#pragma unroll
    for (int q = 0; q < 2; ++q) {
      const int row = rb * 8 + q * 4 + wid;
      const float rstd = rsqrtf(ss[q] * (1.f / 1024.f) + EPS);
#pragma unroll
      for (int i = 0; i < 4; ++i) {
        int col = i * 256 + lane * 4;
        float a = v[q][i].x * rstd * __uint_as_float(pg[i][0]) * (1.f + __uint_as_float(psc[q][i][0])) + __uint_as_float(psh[q][i][0]);
        float b = v[q][i].y * rstd * __uint_as_float(pg[i][1]) * (1.f + __uint_as_float(psc[q][i][1])) + __uint_as_float(psh[q][i][1]);
        float c = v[q][i].z * rstd * __uint_as_float(pg[i][2]) * (1.f + __uint_as_float(psc[q][i][2])) + __uint_as_float(psh[q][i][2]);
        float d = v[q][i].w * rstd * __uint_as_float(pg[i][3]) * (1.f + __uint_as_float(psc[q][i][3])) + __uint_as_float(psh[q][i][3]);
        *(uint2*)(h + (size_t)row * DM + col) = make_uint2(pack2(a, b), pack2(c, d));
        if (first) *(float4*)(p.out + (size_t)row * DM + col) = v[q][i];
      }
    }
  }
}

DI void phase_ffn_gu(const Params& p, int l, int f, char* smem) {
  const u16* A = (const u16*)(p.ws + O_H);
  const u16* Bt = (const u16*)(p.ws + O_WGU) + (size_t)(l * 2 + f) * NGU * DM;
  u16* act = (u16*)(p.ws + O_BIG);
  auto epi = [&](f32x4 (&acc)[4][4], int mb, int nb, int lane) {
    const int l15 = lane & 15, quad = lane >> 4;
#pragma unroll
    for (int mi = 0; mi < 4; ++mi)
#pragma unroll
      for (int pq = 0; pq < 2; ++pq) {
        int c = ((nb >> 5) + pq) * 16 + l15;
#pragma unroll
        for (int j = 0; j < 4; ++j) {
          int row = mb + mi * 16 + quad * 4 + j;
          float gt = acc[mi][2 * pq][j], up = acc[mi][2 * pq + 1][j];
          act[(size_t)row * DFF + c] = f2bf(gt * sigmoidf_(gt) * up);
        }
      }
  };
  const int nM = T / 128, nN = NGU / 128;
  for (int t = bid_(); t < nM * nN; t += gridDim.x) {
    int mt, nt; tile_mn(t, nM, nN, mt, nt);
    gemm_tile(A, DM, Bt, DM, DM, mt * 128, nt * 128, smem, epi);
  }
}

DI void phase_gemm_resid(const Params& p, const u16* A, int K, const u16* Bt, int l, int gidx, float coef, char* smem) {
  const float* mod = (const float*)(p.ws + O_MOD) + (size_t)l * 3 * 9216 + (size_t)gidx * 1024;
  float* x = p.out;
  auto epi = [&](f32x4 (&acc)[4][4], int mb, int nb, int lane) {
    const int l15 = lane & 15, quad = lane >> 4;
    const float* gm = mod + (size_t)cond_of(mb) * 9216;
#pragma unroll
    for (int ni = 0; ni < 4; ++ni) {
      int col = nb + ni * 16 + l15;
      float gt = coef * gm[col];
      float* xp = x + (size_t)(mb + quad * 4) * DM + col;
      float xv[16];
#pragma unroll
      for (int mi = 0; mi < 4; ++mi)
#pragma unroll
        for (int j = 0; j < 4; ++j) GLOAD4(xv[mi * 4 + j], xp + (size_t)(mi * 16 + j) * DM);
      asm volatile("s_waitcnt vmcnt(0)" : "+v"(xv[0]), "+v"(xv[1]), "+v"(xv[2]), "+v"(xv[3]), "+v"(xv[4]), "+v"(xv[5]), "+v"(xv[6]), "+v"(xv[7]),
                   "+v"(xv[8]), "+v"(xv[9]), "+v"(xv[10]), "+v"(xv[11]), "+v"(xv[12]), "+v"(xv[13]), "+v"(xv[14]), "+v"(xv[15]) :: "memory");
#pragma unroll
      for (int mi = 0; mi < 4; ++mi)
#pragma unroll
        for (int j = 0; j < 4; ++j) xp[(size_t)(mi * 16 + j) * DM] = xv[mi * 4 + j] + gt * acc[mi][ni][j];
    }
  };
  const int nM = T / 128, nN = DM / 128;
  for (int t = bid_(); t < nM * nN; t += gridDim.x) {
    int mt, nt; tile_mn(t, nM, nN, mt, nt);
    gemm_tile(A, K, Bt, K, K, mt * 128, nt * 128, smem, epi);
  }
}

DI void phase_win(const Params& p, int l, char* smem) {
  const u16* A = (const u16*)(p.ws + O_H);
  const u16* Bt = (const u16*)(p.ws + O_WIN) + (size_t)l * NINP * DM;
  u16* ubf = (u16*)(p.ws + O_UBF);
  float* um = (float*)(p.ws + O_UM);
  auto epi = [&](f32x4 (&acc)[4][4], int mb, int nb, int lane) {
    const int l15 = lane & 15, quad = lane >> 4;
#pragma unroll
    for (int ni = 0; ni < 4; ++ni) {
      int col = nb + ni * 16 + l15;
#pragma unroll
      for (int mi = 0; mi < 4; ++mi)
#pragma unroll
        for (int j = 0; j < 4; ++j) {
          int row = mb + mi * 16 + quad * 4 + j;
          if (col < 1280) ubf[(size_t)row * 1280 + col] = f2bf(acc[mi][ni][j]);
          else if (col < NIN) um[(size_t)row * 928 + (col - 1280)] = acc[mi][ni][j];
        }
    }
  };
  const int nM = T / 128, nN = NINP / 128;
  for (int t = bid_(); t < nM * nN; t += gridDim.x) {
    int mt, nt; tile_mn(t, nM, nN, mt, nt);
    gemm_tile(A, DM, Bt, DM, DM, mt * 128, nt * 128, smem, epi);
  }
}

DI void mixprep_rows(const Params& p, int l, int item) {
  const int tid = tid_(), lane = tid & 63, wid = tid >> 6;
  int row = item * 4 + wid;
  u16* cqn = (u16*)(p.ws + O_CQN);
  u16* ckvn = (u16*)(p.ws + O_CKVN);
  float* krr = (float*)(p.ws + O_KRR);
  float* krss = (float*)(p.ws + O_KRSS);
  const float* g1 = p.mla_qk_norm_g + (size_t)(l * 2 + 1) * 96;
  if (row < T) {
    const float* um = (const float*)(p.ws + O_UM) + (size_t)row * 928;
    float lq_[6], lgq_[6], lkr_, lg1_; u32x4 lkv_, lgkv_; f32x2_t lcs_;
    const int jj_ = lane & 31;
    int rpos_ = 0;
    if (row >= TC) { int tpos = (row - TC) & 4095; rpos_ = (jj_ >> 4) == 0 ? (tpos >> 6) : (tpos & 63); }
#pragma unroll
    for (int i = 0; i < 6; ++i) { GLOAD4(lq_[i], um + i * 64 + lane); GLOAD4(lgq_[i], p.mla_q_norm_g + l * 384 + i * 64 + lane); }
    GLOAD16(lkv_, um + 384 + lane * 4);
    GLOAD16(lgkv_, p.mla_kv_norm_g + l * 256 + lane * 4);
    GLOAD4(lkr_, um + 640 + jj_);
    GLOAD4(lg1_, g1 + 64 + jj_);
    GLOAD8(lcs_, (const float2*)(p.ws + O_TAB) + 4432 + rpos_ * 8 + (jj_ & 7));
    asm volatile("s_waitcnt vmcnt(0)" : "+v"(lq_[0]), "+v"(lq_[1]), "+v"(lq_[2]), "+v"(lq_[3]), "+v"(lq_[4]), "+v"(lq_[5]),
                 "+v"(lgq_[0]), "+v"(lgq_[1]), "+v"(lgq_[2]), "+v"(lgq_[3]), "+v"(lgq_[4]), "+v"(lgq_[5]),
                 "+v"(lkv_), "+v"(lgkv_), "+v"(lkr_), "+v"(lg1_), "+v"(lcs_) :: "memory");
    {
      float v[6]; float ss = 0.f;
#pragma unroll
      for (int i = 0; i < 6; ++i) { v[i] = lq_[i]; ss += v[i] * v[i]; }
      ss = wave_sum(ss);
      float rstd = rsqrtf(ss * (1.f / 384.f) + EPS);
#pragma unroll
      for (int i = 0; i < 6; ++i) cqn[(size_t)row * 384 + i * 64 + lane] = f2bf(v[i] * rstd * lgq_[i]);
    }
    {
      float4 v = make_float4(__uint_as_float(lkv_[0]), __uint_as_float(lkv_[1]), __uint_as_float(lkv_[2]), __uint_as_float(lkv_[3]));
      float ss = wave_sum(v.x * v.x + v.y * v.y + v.z * v.z + v.w * v.w);
      float rstd = rsqrtf(ss * (1.f / 256.f) + EPS);
      float4 g = make_float4(__uint_as_float(lgkv_[0]), __uint_as_float(lgkv_[1]), __uint_as_float(lgkv_[2]), __uint_as_float(lgkv_[3]));
      float4 o = make_float4(v.x * rstd * g.x, v.y * rstd * g.y, v.z * rstd * g.z, v.w * rstd * g.w);
      if (row < TC) {
        int b = row >> 8, s = row & 255;
        *(float4*)(p.out + OUT_CKV + ((size_t)(b * 2 + l) * 256 + s) * 256 + lane * 4) = o;
      }
      *(uint2*)(ckvn + (size_t)row * 256 + lane * 4) = make_uint2(pack2(o.x, o.y), pack2(o.z, o.w));
    }
    {
      int j = lane & 31;
      float kr = lkr_;
      if (row < TC && lane < 32) {
        int b = row >> 8, s = row & 255;
        p.out[OUT_KR + ((size_t)(b * 2 + l) * 256 + s) * 32 + j] = kr;
      }
      float ss = kr * kr;
#pragma unroll
      for (int o = 16; o > 0; o >>= 1) ss += __shfl_xor(ss, o);
      float val = kr * lg1_;
      float pv = __shfl_xor(val, 8);
      float outv = val;
      if (row >= TC) {
        int half = (j >> 3) & 1;
        float cs = lcs_[0], sn = lcs_[1];
        outv = half == 0 ? val * cs - pv * sn : val * cs + pv * sn;
      }
      if (lane < 32) krr[(size_t)row * 32 + j] = outv;
      if (lane == 0) krss[row] = ss;
    }
  } else {
    int cr = row - T;
    int b = cr >> 9, pp = cr & 511;
    const float* src = p.cache_ckv + ((size_t)(b * 2 + l) * 512 + pp) * 256;
    float4 v = *(const float4*)(src + lane * 4);
    *(uint2*)(ckvn + (size_t)row * 256 + lane * 4) = make_uint2(pack2(v.x, v.y), pack2(v.z, v.w));
    int j = lane & 31;
    float kr = p.cache_krope[((size_t)(b * 2 + l) * 512 + pp) * 32 + j];
    float ss = kr * kr;
#pragma unroll
    for (int o = 16; o > 0; o >>= 1) ss += __shfl_xor(ss, o);
    if (lane < 32) krr[(size_t)row * 32 + j] = kr * g1[64 + j];
    if (lane == 0) krss[row] = ss;
  }
}

DI int hg_entry(int cid, int chunk) { return cid < 256 ? cid * 2 + chunk : 512 + (cid - 256) * 32 + chunk; }

template <bool OUT>
DI void hgrn_chunk(const Params& p, int l, int cid, int chunk, char* smem) {
  const int tid = tid_(), lane = tid & 63, w = tid >> 6;
  int b, hh, dir, L, row0;
  if (cid < 256) { b = cid >> 3; hh = (cid >> 1) & 3; dir = cid & 1; L = 256; row0 = b * 256; }
  else { int c2 = cid - 256; b = c2 >> 3; hh = (c2 >> 1) & 3; dir = c2 & 1; L = 4096; row0 = TC + b * 4096; }
  float* sf = (float*)smem;
  float* sk = sf + 2048;
  float* sq = sk + 2048;
  float* sv = sq + 2048;
  float* so = sv + 2048;
  const u16* ubf = (const u16*)(p.ws + O_UBF);
  float* sloc = (float*)(p.ws + O_SLOC);
  float* dtot = (float*)(p.ws + O_DTOT);
  float S[16];
  if (OUT) {
    if (cid < 256) {
      if (chunk == 0) {
#pragma unroll
        for (int i = 0; i < 16; ++i) S[i] = 0.f;
      } else {
        const float* s = sloc + (size_t)hg_entry(cid, 0) * 4096;
#pragma unroll
        for (int i = 0; i < 16; ++i) S[i] = s[(16 * w + i) * 64 + lane];
      }
    } else {
      const float* s = (const float*)(p.ws + O_SIN) + (size_t)(hg_entry(cid, chunk) - 512) * 4096;
#pragma unroll
      for (int i = 0; i < 16; ++i) S[i] = s[(16 * w + i) * 64 + lane];
    }
  } else {
#pragma unroll
    for (int i = 0; i < 16; ++i) S[i] = 0.f;
  }
  const int kcol = tid & 63;
  float lb = 0.f;
  if (l == 1) {
    float a0 = p.hgrn_lb[(0 * 2 + dir) * 256 + hh * 64 + kcol], a1 = p.hgrn_lb[(1 * 2 + dir) * 256 + hh * 64 + kcol];
    lb = 1.f / (1.f + __expf(a0 - a1));
  }
  float dprod = 1.f;
  unsigned rq[8], rf[8], rv[8];
#define GLOADU16(dst, ptr) asm volatile("global_load_ushort %0, %1, off" : "=v"(dst) : "v"(ptr) : "memory")
#define HG_ISSUE(SC)                                                                  \
  _Pragma("unroll") for (int n = 0; n < 8; ++n) {                                     \
    int i_ = (tid >> 6) + 4 * n;                                                      \
    int tau_ = chunk * 128 + (SC) * 32 + i_;                                          \
    int tpos_ = dir ? (L - 1 - tau_) : tau_;                                          \
    const u16* ur_ = ubf + (size_t)(row0 + tpos_) * 1280 + hh * 64 + kcol;           \
    GLOADU16(rf[n], ur_ + 256 + dir * 256);                                           \
    GLOADU16(rv[n], ur_ + 768);                                                       \
    if (OUT) GLOADU16(rq[n], ur_);                                                    \
  }
  f32x2_t S2[8];
#pragma unroll
  for (int j = 0; j < 8; ++j) S2[j] = (f32x2_t){S[2 * j], S[2 * j + 1]};
  HG_ISSUE(0)
  for (int sc = 0; sc < 4; ++sc) {
    asm volatile("s_waitcnt vmcnt(0)" : "+v"(rf[0]), "+v"(rf[1]), "+v"(rf[2]), "+v"(rf[3]), "+v"(rf[4]), "+v"(rf[5]), "+v"(rf[6]), "+v"(rf[7]),
                 "+v"(rv[0]), "+v"(rv[1]), "+v"(rv[2]), "+v"(rv[3]), "+v"(rv[4]), "+v"(rv[5]), "+v"(rv[6]), "+v"(rv[7]) :: "memory");
    if (OUT) asm volatile("" : "+v"(rq[0]), "+v"(rq[1]), "+v"(rq[2]), "+v"(rq[3]), "+v"(rq[4]), "+v"(rq[5]), "+v"(rq[6]), "+v"(rq[7]) :: "memory");
#pragma unroll
    for (int n = 0; n < 8; ++n) {
      int i = (tid >> 6) + 4 * n;
      float fr = __uint_as_float(rf[n] << 16);
      float e = __expf(-fr);
      float sg = __builtin_amdgcn_rcpf(1.f + e);
      float om = 1.f / (1.f + __expf(fr));
      float f = lb + (1.f - lb) * sg;
      sf[i * 64 + kcol] = f;
      dprod *= f;
      sv[i * 64 + kcol] = __uint_as_float(rv[n] << 16);
      if (OUT) { float q = __uint_as_float(rq[n] << 16); sq[i * 64 + kcol] = q * sigmoidf_(q); }
    }
    if (sc + 1 < 4) { HG_ISSUE(sc + 1) }
    __syncthreads();
    for (int i = 0; i < 32; ++i) {
      const float v = sv[i * 64 + lane];
      const f32x2_t vv = {v, v};
      f32x2_t o2 = {0.f, 0.f};
#pragma unroll
      for (int a = 0; a < 4; ++a) {
        const f32x4 f4 = *(const f32x4*)(sf + i * 64 + 16 * w + 4 * a);
        const f32x2_t fa = {f4[0], f4[1]}, fb = {f4[2], f4[3]};
        S2[2 * a] = __builtin_elementwise_fma(fa, S2[2 * a] - vv, vv);
        S2[2 * a + 1] = __builtin_elementwise_fma(fb, S2[2 * a + 1] - vv, vv);
        if (OUT) {
          const f32x4 q4 = *(const f32x4*)(sq + i * 64 + 16 * w + 4 * a);
          const f32x2_t qa = {q4[0], q4[1]}, qb = {q4[2], q4[3]};
          o2 = __builtin_elementwise_fma(qa, S2[2 * a], o2);
          o2 = __builtin_elementwise_fma(qb, S2[2 * a + 1], o2);
        }
      }
      if (OUT) so[(i * 4 + w) * 64 + lane] = o2[0] + o2[1];
    }
    __syncthreads();
    if (OUT) {
      float* od = (float*)(p.ws + (dir ? O_OB : O_OF));
#pragma unroll
      for (int n = 0; n < 8; ++n) {
        int i = (tid >> 6) + 4 * n;
        int tau = chunk * 128 + sc * 32 + i;
        int tpos = dir ? (L - 1 - tau) : tau;
        float o = so[(i * 4 + 0) * 64 + kcol] + so[(i * 4 + 1) * 64 + kcol] + so[(i * 4 + 2) * 64 + kcol] +
                  so[(i * 4 + 3) * 64 + kcol];
        od[(size_t)(row0 + tpos) * 256 + hh * 64 + kcol] = o;
      }
      __syncthreads();
    }
  }
#pragma unroll
  for (int j = 0; j < 8; ++j) { S[2 * j] = S2[j][0]; S[2 * j + 1] = S2[j][1]; }
  if (!OUT) {
    int e = hg_entry(cid, chunk);
    float* s = sloc + (size_t)e * 4096;
#pragma unroll
    for (int i = 0; i < 16; ++i) s[(16 * w + i) * 64 + lane] = S[i];
    sf[tid] = dprod;
    __syncthreads();
    if (tid < 64) dtot[(size_t)e * 64 + tid] = sf[tid] * sf[64 + tid] * sf[128 + tid] * sf[192 + tid];
    __syncthreads();
  } else if (cid < 256 && chunk == 1) {
    float* s = p.out + OUT_ST + ((size_t)((b * 2 + l) * 2 + dir) * 4 + hh) * 4096;
#pragma unroll
    for (int i = 0; i < 16; ++i) s[(16 * w + i) * 64 + lane] = S[i];
  }
}

template <int R, int NK>
DI void fft_a(const Params& p, int tb, int l2, int k1base, char* smem) {
  const int col = tid_();
  const float2* W = (const float2*)(p.ws + O_TAB) + (R == 16 ? TAB_W16 : TAB_W64);
  const float2* tabL = (const float2*)(p.ws + O_TAB) + (R == 16 ? 80 : 336);
  const float* um = (const float*)(p.ws + O_UM) + (size_t)(tb + l2) * 928 + 672 + col;
  float x[R];
#pragma unroll
  for (int l1 = 0; l1 < R; ++l1) GLOAD4(x[l1], um + (size_t)(R * l1) * 928);
#pragma unroll
  for (int l1 = 0; l1 < R; l1 += 8)
    asm volatile("s_waitcnt vmcnt(0)" : "+v"(x[l1]), "+v"(x[l1 + 1]), "+v"(x[l1 + 2]), "+v"(x[l1 + 3]), "+v"(x[l1 + 4]), "+v"(x[l1 + 5]), "+v"(x[l1 + 6]), "+v"(x[l1 + 7]) :: "memory");
  float2* y = (float2*)(p.ws + O_YFFT);
  float2* sW = (float2*)smem;
  float2* sT = sW + NK * R;
  for (int i = col; i < NK * R; i += 256) sW[i] = W[k1base * R + i];
  if (col < NK) sT[col] = tabL[(k1base + col) * l2];
  __syncthreads();
  for (int k = 0; k < NK; ++k) {
    const int k1 = k1base + k;
    const float2* wr = sW + k * R;
    float yr = 0.f, yi = 0.f;
#pragma unroll
    for (int l1 = 0; l1 < R; ++l1) { float2 w = wr[l1]; yr += x[l1] * w.x; yi -= x[l1] * w.y; if ((l1 & 7) == 7) __builtin_amdgcn_sched_barrier(0); }
    float2 tw = sT[k];
    float re = yr * tw.x + yi * tw.y;
    float im = yi * tw.x - yr * tw.y;
    y[(size_t)(tb + k1 * R + l2) * 256 + col] = make_float2(re, im);
  }
  __syncthreads();
}
template <int R, int NK>
DI void fft_c(const Params& p, int tb, int k1, int k2base, char* smem) {
  const int col = tid_();
  const float2* W = (const float2*)(p.ws + O_TAB) + (R == 16 ? TAB_W16 : TAB_W64);
  const float2* y = (const float2*)(p.ws + O_YFFT) + (size_t)(tb + k1 * R) * 256 + col;
  f32x2_t v[R];
#pragma unroll
  for (int l2 = 0; l2 < R; ++l2) GLOAD8(v[l2], y + (size_t)l2 * 256);
#pragma unroll
  for (int l2 = 0; l2 < R; l2 += 8)
    asm volatile("s_waitcnt vmcnt(0)" : "+v"(v[l2]), "+v"(v[l2 + 1]), "+v"(v[l2 + 2]), "+v"(v[l2 + 3]), "+v"(v[l2 + 4]), "+v"(v[l2 + 5]), "+v"(v[l2 + 6]), "+v"(v[l2 + 7]) :: "memory");
  u16* xb = (u16*)(p.ws + O_XBUF);
  const int g = col >> 6, cc = col & 63;
  float2* sW = (float2*)smem;
  for (int i = col; i < NK * R; i += 256) sW[i] = W[k2base * R + i];
  __syncthreads();
  for (int k = 0; k < NK; ++k) {
    const int k2 = k2base + k;
    const float2* wr = sW + k * R;
    float xr = 0.f, xi = 0.f;
#pragma unroll
    for (int l2 = 0; l2 < R; ++l2) {
      float2 w = wr[l2];
      xr += v[l2][0] * w.x + v[l2][1] * w.y;
      xi += v[l2][1] * w.x - v[l2][0] * w.y;
      if ((l2 & 7) == 7) __builtin_amdgcn_sched_barrier(0);
    }
    int row = tb + k1 + R * k2;
    xb[(size_t)row * 512 + g * 128 + cc] = f2bf(xr);
    xb[(size_t)row * 512 + g * 128 + 64 + cc] = f2bf(xi);
  }
  __syncthreads();
}

constexpr int N6_HA = 16 * 31 + 256, N6_FA = 256 + 512, N6_MP = TK / 4;
DI void phase6(const Params& p, int l, char* smem) {
  for (int it = bid_(); it < N6_HA + N6_FA + N6_MP; it += gridDim.x) {
    int t = it;
    if (t < N6_HA) {
      int cid, chunk;
      if (t < 496) { cid = 256 + t / 31; chunk = t % 31; } else { cid = t - 496; chunk = 0; }
      hgrn_chunk<false>(p, l, cid, chunk, smem);
      continue;
    }
    t -= N6_HA;
    if (t < N6_FA) {
      if (t < 256) { int b = t >> 7, r = t & 127; fft_a<64, 32>(p, TC + b * 4096, r >> 1, (r & 1) * 32, smem); }
      else { int u = t - 256; fft_a<16, 16>(p, (u >> 4) * 256, u & 15, 0, smem); }
      continue;
    }
    t -= N6_FA;
    mixprep_rows(p, l, t);
  }
}

DI void hgrn_prefix(const Params& p, int l, int c2, int eb) {
  const int tid = tid_();
  const int e = eb * 256 + tid, k = e >> 6;
  const int b = c2 >> 3, hh = (c2 >> 1) & 3, dir = c2 & 1;
  const float* sloc = (const float*)(p.ws + O_SLOC) + (size_t)(512 + c2 * 32) * 4096 + e;
  const float* dtot = (const float*)(p.ws + O_DTOT) + (size_t)(512 + c2 * 32) * 64 + k;
  float* sin = (float*)(p.ws + O_SIN) + (size_t)(c2 * 32) * 4096 + e;
  float sl[32], dd[32];
  sl[31] = 0.f; dd[31] = 0.f;
#pragma unroll
  for (int j = 0; j < 31; ++j) { GLOAD4(sl[j], sloc + (size_t)j * 4096); GLOAD4(dd[j], dtot + (size_t)j * 64); }
  float S = p.state_hgrn[((size_t)((b * 2 + l) * 2 + dir) * 4 + hh) * 4096 + e];
#pragma unroll
  for (int j = 0; j < 32; j += 8)
    asm volatile("s_waitcnt vmcnt(0)" : "+v"(sl[j]), "+v"(sl[j + 1]), "+v"(sl[j + 2]), "+v"(sl[j + 3]), "+v"(sl[j + 4]), "+v"(sl[j + 5]), "+v"(sl[j + 6]), "+v"(sl[j + 7]),
                 "+v"(dd[j]), "+v"(dd[j + 1]), "+v"(dd[j + 2]), "+v"(dd[j + 3]), "+v"(dd[j + 4]), "+v"(dd[j + 5]), "+v"(dd[j + 6]), "+v"(dd[j + 7]) :: "memory");
  sin[0] = S;
#pragma unroll
  for (int j = 0; j < 31; ++j) { S = dd[j] * S + sl[j]; sin[(size_t)(j + 1) * 4096] = S; }
}

constexpr int N7_Q = 128 * 6, N7_KV = (TK / 128) * 8, N7_FC = 256 + 512, N7_HB = 256;
DI void phase7(const Params& p, int l, char* smem) {
  u16* qraw = (u16*)(p.ws + O_H);
  const u16* cqn = (const u16*)(p.ws + O_CQN);
  const u16* ckvn = (const u16*)(p.ws + O_CKVN);
  const u16* wq = (const u16*)(p.ws + O_WQ) + (size_t)l * 768 * 384;
  const u16* wkv = (const u16*)(p.ws + O_WKV) + (size_t)l * 1024 * 256;
  const float* krr = (const float*)(p.ws + O_KRR);
  const float* krss = (const float*)(p.ws + O_KRSS);
  const float* g1 = p.mla_qk_norm_g + (size_t)(l * 2 + 1) * 96;
  u16* kbuf = (u16*)(p.ws + O_KBUF);
  u16* vt = (u16*)(p.ws + O_VT);
  auto epi_q = [&](f32x4 (&acc)[4][4], int mb, int nb, int lane) {
    const int l15 = lane & 15, quad = lane >> 4;
#pragma unroll
    for (int ni = 0; ni < 4; ++ni)
#pragma unroll
      for (int mi = 0; mi < 4; ++mi)
#pragma unroll
        for (int j = 0; j < 4; ++j) {
          int row = mb + mi * 16 + quad * 4 + j;
          qraw[(size_t)row * 768 + nb + ni * 16 + l15] = f2bf(acc[mi][ni][j]);
        }
  };
  auto epi_kv = [&](f32x4 (&acc)[4][4], int mb, int nb, int lane) {
    const int l15 = lane & 15, quad = lane >> 4;
    const int hd = nb >> 7, isv = (nb >> 6) & 1;
#pragma unroll
    for (int mi = 0; mi < 4; ++mi) {
      int r0 = mb + mi * 16 + quad * 4;
      size_t kb_base, vt_base; int key0, Lk;
      if (r0 < TC) { int b = r0 >> 8; key0 = r0 & 255; Lk = 256; kb_base = (size_t)(b * 8 + hd) * 256 * 96; vt_base = (size_t)(b * 8 + hd) * 64 * 256; }
      else {
        int b;
        if (r0 < T) { b = (r0 - TC) >> 12; key0 = 512 + ((r0 - TC) & 4095); }
        else { b = (r0 - T) >> 9; key0 = (r0 - T) & 511; }
        Lk = 4608;
        kb_base = (size_t)TC * 8 * 96 + (size_t)(b * 8 + hd) * 4608 * 96;
        vt_base = (size_t)TC * 8 * 64 + (size_t)(b * 8 + hd) * 64 * 4608;
      }
      if (!isv) {
        float kss[4]; f32x2_t kr2v[4];
#pragma unroll
        for (int j = 0; j < 4; ++j) { GLOAD4(kss[j], krss + (r0 + j)); GLOAD8(kr2v[j], krr + (size_t)(r0 + j) * 32 + l15 * 2); }
        asm volatile("s_waitcnt vmcnt(0)" : "+v"(kss[0]), "+v"(kss[1]), "+v"(kss[2]), "+v"(kss[3]), "+v"(kr2v[0]), "+v"(kr2v[1]), "+v"(kr2v[2]), "+v"(kr2v[3]) :: "memory");
#pragma unroll
        for (int j = 0; j < 4; ++j) {
          float ss = 0.f;
#pragma unroll
          for (int ni = 0; ni < 4; ++ni) ss += acc[mi][ni][j] * acc[mi][ni][j];
          ss += __shfl_xor(ss, 1); ss += __shfl_xor(ss, 2); ss += __shfl_xor(ss, 4); ss += __shfl_xor(ss, 8);
          int row = r0 + j;
          float rstd = rsqrtf((ss + kss[j]) * (1.f / 96.f) + EPS);
          u16* kd = kbuf + kb_base + (size_t)(key0 + j) * 96;
#pragma unroll
          for (int ni = 0; ni < 4; ++ni) kd[ni * 16 + l15] = f2bf(acc[mi][ni][j] * rstd * g1[ni * 16 + l15]);
          *(unsigned*)(kd + 64 + l15 * 2) = pack2(kr2v[j][0] * rstd, kr2v[j][1] * rstd);
        }
      } else {
#pragma unroll
        for (int ni = 0; ni < 4; ++ni) {
          int d = ni * 16 + l15;
          *(uint2*)(vt + vt_base + (size_t)d * Lk + key0) =
              make_uint2(pack2(acc[mi][ni][0], acc[mi][ni][1]), pack2(acc[mi][ni][2], acc[mi][ni][3]));
        }
      }
    }
  };
  for (int it = bid_(); it < N7_KV + N7_Q + N7_FC + N7_HB; it += gridDim.x) {
    int t = it;
    if (t < N7_KV) { gemm_tile(ckvn, 256, wkv, 256, 256, (t >> 3) * 128, (t & 7) * 128, smem, epi_kv); continue; }
    t -= N7_KV;
    if (t < N7_Q) { gemm_tile(cqn, 384, wq, 384, 384, (t / 6) * 128, (t % 6) * 128, smem, epi_q); continue; }
    t -= N7_Q;
    if (t < N7_FC) {
      if (t < 256) { int b = t >> 7, r = t & 127; fft_c<64, 32>(p, TC + b * 4096, r >> 1, (r & 1) * 32, smem); }
      else { int u = t - 256; fft_c<16, 16>(p, (u >> 4) * 256, u & 15, 0, smem); }
      continue;
    }
    t -= N7_FC;
    hgrn_prefix(p, l, t >> 4, t & 15);
  }
}

DI int kappa(int r) { return (r & ~12) | ((r & 8) >> 1) | ((r & 4) << 1); }

DI void attn_item(const Params& p, int l, bool lat, int b, int hd, int qt, char* smem) {
  const int tid = tid_(), lane = tid & 63, w = tid >> 6;
  const int r = lane & 31, hh = lane >> 5;
  const int Lk = lat ? 4608 : 256;
  const u16* kb = (const u16*)(p.ws + O_KBUF) + (lat ? (size_t)TC * 8 * 96 + (size_t)(b * 8 + hd) * 4608 * 96 : (size_t)(b * 8 + hd) * 256 * 96);
  const u16* vtb = (const u16*)(p.ws + O_VT) + (lat ? (size_t)TC * 8 * 64 + (size_t)(b * 8 + hd) * 64 * 4608 : (size_t)(b * 8 + hd) * 64 * 256);
  const int qrow = (lat ? TC + b * 4096 : b * 256) + qt * 128 + w * 32 + r;
  bf16x8 qf[6];
  {
    const u16* qp = (const u16*)(p.ws + O_H) + (size_t)qrow * 768 + hd * 96;
    const float* g0 = p.mla_qk_norm_g + (size_t)(l * 2) * 96;
    uint4 raw[6];
    float ss = 0.f;
#pragma unroll
    for (int s = 0; s < 6; ++s) {
      raw[s] = *(const uint4*)(qp + 16 * s + 8 * hh);
      unsigned uu[4] = {raw[s].x, raw[s].y, raw[s].z, raw[s].w};
#pragma unroll
      for (int j = 0; j < 4; ++j) {
        float a = __uint_as_float(uu[j] << 16), c = __uint_as_float(uu[j] & 0xffff0000u);
        ss += a * a + c * c;
      }
    }
    ss += __shfl_xor(ss, 32);
    const float rstd = rsqrtf(ss * (1.f / 96.f) + EPS);
    const float qs = 0.10206207261596577f * 1.4426950408889634f;
    const int tpos = (qrow - TC) & 4095;
    const float2* rtab = (const float2*)(p.ws + O_TAB) + 4432;
#pragma unroll
    for (int s = 0; s < 6; ++s) {
      unsigned uu[4] = {raw[s].x, raw[s].y, raw[s].z, raw[s].w};
      float qv[8];
#pragma unroll
      for (int j = 0; j < 4; ++j) {
        qv[2 * j] = __uint_as_float(uu[j] << 16) * rstd * g0[16 * s + 8 * hh + 2 * j];
        qv[2 * j + 1] = __uint_as_float(uu[j] & 0xffff0000u) * rstd * g0[16 * s + 8 * hh + 2 * j + 1];
      }
      if (s >= 4 && lat) {
        int pos = s == 4 ? (tpos >> 6) : (tpos & 63);
#pragma unroll
        for (int j = 0; j < 8; ++j) {
          float val = qv[j];
          float pv = __shfl_xor(val, 32);
          float2 cs2 = rtab[pos * 8 + j];
          qv[j] = hh == 0 ? val * cs2.x - pv * cs2.y : val * cs2.x + pv * cs2.y;
        }
      }
      unsigned pk[4];
#pragma unroll
      for (int j = 0; j < 4; ++j) pk[j] = pack2(qv[2 * j] * qs, qv[2 * j + 1] * qs);
      uint4 u4 = make_uint4(pk[0], pk[1], pk[2], pk[3]);
      qf[s] = *(bf16x8*)&u4;
    }
  }
  f32x16 o0, o1;
#pragma unroll
  for (int i = 0; i < 16; ++i) { o0[i] = 0.f; o1[i] = 0.f; }
  float lsum = 0.f;
  float mfix;
  {
    const float* gq = p.mla_qk_norm_g + (size_t)(l * 2) * 96;
    float mq = 0.f, mk = 0.f;
    for (int e = 0; e < 96; ++e) { mq = fmaxf(mq, fabsf(gq[e])); mk = fmaxf(mk, fabsf(gq[96 + e])); }
    mfix = fminf(9.797958971132712f * 1.4426950408889634f * mq * mk, 100.f);
  }
  constexpr int KST = 64 * 208, VST = 64 * 144, STG = KST + VST;
  u32x4 a0, a1, a2, a3, a4, b0, b1, b2, b3, b4;
  const u16* kg = kb + tid * 8;
  const u16* vg = vtb + (size_t)(tid >> 3) * Lk + (tid & 7) * 8;
  const int ksoff0 = (tid / 12) * 208 + (tid % 12) * 16;
  const int ksoff1 = ((tid + 256) / 12) * 208 + ((tid + 256) % 12) * 16;
  const int ksoff2 = ((tid + 512) / 12) * 208 + ((tid + 512) % 12) * 16;
  const int vsoff = KST + (tid >> 3) * 144 + (tid & 7) * 16;
  const int nkt = Lk >> 6;
  const unsigned lds0a = (unsigned)(size_t)smem;
#define ATT_GLOAD_S(S, KT)                                               \
  {                                                                      \
    const int kt_ = (KT) < nkt ? (KT) : nkt - 1;                         \
    GLOAD16(S##0, kg + (size_t)kt_ * 6144);                              \
    GLOAD16(S##1, kg + (size_t)kt_ * 6144 + 2048);                       \
    GLOAD16(S##2, kg + (size_t)kt_ * 6144 + 4096);                       \
    GLOAD16(S##3, vg + kt_ * 64);                                        \
    GLOAD16(S##4, vg + (size_t)32 * Lk + kt_ * 64);                      \
  }
#define ATT_SSTORE_S(S, BUF)                                             \
  {                                                                      \
    char* base_ = smem + (BUF) * STG;                                    \
    asm volatile("s_waitcnt vmcnt(5)" : "+v"(S##0), "+v"(S##1), "+v"(S##2), "+v"(S##3), "+v"(S##4) :: "memory"); \
    *(u32x4*)(base_ + ksoff0) = S##0;                                    \
    *(u32x4*)(base_ + ksoff1) = S##1;                                    \
    *(u32x4*)(base_ + ksoff2) = S##2;                                    \
    *(u32x4*)(base_ + vsoff) = S##3;                                     \
    *(u32x4*)(base_ + vsoff + 32 * 144) = S##4;                          \
  }
  const int kr_ = kappa(r);
  auto att_compute = [&](const int bsel) {
    const unsigned kaddr = lds0a + bsel * STG + kr_ * 208 + hh * 16;
    const unsigned vaddr = lds0a + bsel * STG + KST + r * 144 + hh * 16;
    bf16x8 ka[6], kc[6];
    DSR(ka[0], kaddr, 0);    DSR(kc[0], kaddr, 6656);
    DSR(ka[1], kaddr, 32);   DSR(kc[1], kaddr, 6688);
    DSR(ka[2], kaddr, 64);   DSR(kc[2], kaddr, 6720);
    DSR(ka[3], kaddr, 96);   DSR(kc[3], kaddr, 6752);
    DSR(ka[4], kaddr, 128);  DSR(kc[4], kaddr, 6784);
    DSR(ka[5], kaddr, 160);  DSR(kc[5], kaddr, 6816);
    f32x16 s0, s1;
#pragma unroll
    for (int i = 0; i < 16; ++i) { s0[i] = -mfix; s1[i] = -mfix; }
#define ATT_W2(N, X, Y) asm volatile("s_waitcnt lgkmcnt(" #N ")" : "+v"(X), "+v"(Y) :: "memory")
    ATT_W2(10, ka[0], kc[0]);
    s0 = __builtin_amdgcn_mfma_f32_32x32x16_bf16(ka[0], qf[0], s0, 0, 0, 0);
    s1 = __builtin_amdgcn_mfma_f32_32x32x16_bf16(kc[0], qf[0], s1, 0, 0, 0);
    ATT_W2(8, ka[1], kc[1]);
    s0 = __builtin_amdgcn_mfma_f32_32x32x16_bf16(ka[1], qf[1], s0, 0, 0, 0);
    s1 = __builtin_amdgcn_mfma_f32_32x32x16_bf16(kc[1], qf[1], s1, 0, 0, 0);
    ATT_W2(6, ka[2], kc[2]);
    s0 = __builtin_amdgcn_mfma_f32_32x32x16_bf16(ka[2], qf[2], s0, 0, 0, 0);
    s1 = __builtin_amdgcn_mfma_f32_32x32x16_bf16(kc[2], qf[2], s1, 0, 0, 0);
    ATT_W2(4, ka[3], kc[3]);
    s0 = __builtin_amdgcn_mfma_f32_32x32x16_bf16(ka[3], qf[3], s0, 0, 0, 0);
    s1 = __builtin_amdgcn_mfma_f32_32x32x16_bf16(kc[3], qf[3], s1, 0, 0, 0);
    ATT_W2(2, ka[4], kc[4]);
    s0 = __builtin_amdgcn_mfma_f32_32x32x16_bf16(ka[4], qf[4], s0, 0, 0, 0);
    s1 = __builtin_amdgcn_mfma_f32_32x32x16_bf16(kc[4], qf[4], s1, 0, 0, 0);
    ATT_W2(0, ka[5], kc[5]);
    s0 = __builtin_amdgcn_mfma_f32_32x32x16_bf16(ka[5], qf[5], s0, 0, 0, 0);
    s1 = __builtin_amdgcn_mfma_f32_32x32x16_bf16(kc[5], qf[5], s1, 0, 0, 0);
    __builtin_amdgcn_sched_barrier(0);
    bf16x8 va[4], vc[4];
    DSR(va[0], vaddr, 0);   DSR(vc[0], vaddr, 4608);
    DSR(va[1], vaddr, 32);  DSR(vc[1], vaddr, 4640);
    DSR(va[2], vaddr, 64);  DSR(vc[2], vaddr, 4672);
    DSR(va[3], vaddr, 96);  DSR(vc[3], vaddr, 4704);
#pragma unroll
    for (int i = 0; i < 16; ++i) { s0[i] = __builtin_amdgcn_exp2f(s0[i]); lsum += s0[i]; s1[i] = __builtin_amdgcn_exp2f(s1[i]); lsum += s1[i]; }
    bf16x8 pb[4];
#pragma unroll
    for (int kbk = 0; kbk < 2; ++kbk)
#pragma unroll
      for (int t2 = 0; t2 < 2; ++t2) {
        unsigned pk[4];
#pragma unroll
        for (int j = 0; j < 4; ++j) {
          float x0 = kbk ? s1[8 * t2 + 2 * j] : s0[8 * t2 + 2 * j];
          float x1 = kbk ? s1[8 * t2 + 2 * j + 1] : s0[8 * t2 + 2 * j + 1];
          pk[j] = pack2(x0, x1);
        }
        uint4 u4 = make_uint4(pk[0], pk[1], pk[2], pk[3]);
        pb[kbk * 2 + t2] = *(bf16x8*)&u4;
      }
    ATT_W2(6, va[0], vc[0]);
    o0 = __builtin_amdgcn_mfma_f32_32x32x16_bf16(va[0], pb[0], o0, 0, 0, 0);
    o1 = __builtin_amdgcn_mfma_f32_32x32x16_bf16(vc[0], pb[0], o1, 0, 0, 0);
    ATT_W2(4, va[1], vc[1]);
    o0 = __builtin_amdgcn_mfma_f32_32x32x16_bf16(va[1], pb[1], o0, 0, 0, 0);
    o1 = __builtin_amdgcn_mfma_f32_32x32x16_bf16(vc[1], pb[1], o1, 0, 0, 0);
    ATT_W2(2, va[2], vc[2]);
    o0 = __builtin_amdgcn_mfma_f32_32x32x16_bf16(va[2], pb[2], o0, 0, 0, 0);
    o1 = __builtin_amdgcn_mfma_f32_32x32x16_bf16(vc[2], pb[2], o1, 0, 0, 0);
    ATT_W2(0, va[3], vc[3]);
    o0 = __builtin_amdgcn_mfma_f32_32x32x16_bf16(va[3], pb[3], o0, 0, 0, 0);
    o1 = __builtin_amdgcn_mfma_f32_32x32x16_bf16(vc[3], pb[3], o1, 0, 0, 0);
    __builtin_amdgcn_sched_barrier(0);
  };
  ATT_GLOAD_S(a, 0)
  ATT_GLOAD_S(b, 1)
  ATT_SSTORE_S(a, 0)
  __syncthreads();
  for (int kt = 0; kt < nkt; kt += 2) {
    ATT_GLOAD_S(a, kt + 2)
    att_compute(0);
    ATT_SSTORE_S(b, 1)
    __syncthreads();
    ATT_GLOAD_S(b, kt + 3)
    att_compute(1);
    ATT_SSTORE_S(a, 0)
    __syncthreads();
  }
  asm volatile("s_waitcnt vmcnt(0)" : "+v"(a0), "+v"(a1), "+v"(a2), "+v"(a3), "+v"(a4), "+v"(b0), "+v"(b1), "+v"(b2), "+v"(b3), "+v"(b4) :: "memory");
  lsum += __shfl_xor(lsum, 32);
  float inv = 1.f / lsum;
  u16* om = (u16*)(p.ws + O_OMLA) + (size_t)qrow * 512 + hd * 64;
#pragma unroll
  for (int gq = 0; gq < 4; ++gq) {
    int d = 8 * gq + 4 * hh;
    *(uint2*)(om + d) = make_uint2(pack2(o0[4 * gq] * inv, o0[4 * gq + 1] * inv), pack2(o0[4 * gq + 2] * inv, o0[4 * gq + 3] * inv));
    *(uint2*)(om + 32 + d) = make_uint2(pack2(o1[4 * gq] * inv, o1[4 * gq + 1] * inv), pack2(o1[4 * gq + 2] * inv, o1[4 * gq + 3] * inv));
  }
}

constexpr int N8_AL = 512, N8_AC = 512, N8_HC = 1024, N8_F2 = 256;
DI void phase8(const Params& p, int l, char* smem) {
  const u16* xb = (const u16*)(p.ws + O_XBUF);
  const u16* wf = (const u16*)(p.ws + O_WF) + (size_t)l * 256 * 512;
  u16* ofn = (u16*)(p.ws + O_OFN);
  auto epi_f = [&](f32x4 (&acc)[4][4], int mb, int nb, int lane) {
    const int l15 = lane & 15, quad = lane >> 4;
    const float sc = mb < TC ? (1.f / 128.f) : (1.f / 512.f);
#pragma unroll
    for (int ni = 0; ni < 4; ++ni)
#pragma unroll
      for (int mi = 0; mi < 4; ++mi)
#pragma unroll
        for (int j = 0; j < 4; ++j) {
          int row = mb + mi * 16 + quad * 4 + j;
          ofn[(size_t)row * 256 + nb + ni * 16 + l15] = f2bf(acc[mi][ni][j] * sc);
        }
  };
  for (int it = bid_(); it < N8_AL + N8_AC + N8_HC + N8_F2; it += gridDim.x) {
    int t = it;
    if (t < N8_AL + N8_AC) {
      bool lat = t < N8_AL;
      int b, hd, qt;
      if (lat) {
        int x = t & 7, y = t >> 3;
        int bh = x * 2 + (y >> 5);
        qt = y & 31; b = bh >> 3; hd = bh & 7;
      } else {
        int u = t - N8_AL;
        b = u >> 4; hd = (u >> 1) & 7; qt = u & 1;
      }
      attn_item(p, l, lat, b, hd, qt, smem);
      continue;
    }
    t -= N8_AL + N8_AC;
    if (t < N8_HC) {
      int cid, chunk;
      if (t < 512) { cid = 256 + (t >> 5); chunk = t & 31; }
      else { int u = t - 512; cid = u >> 1; chunk = u & 1; }
      hgrn_chunk<true>(p, l, cid, chunk, smem);
      continue;
    }
    t -= N8_HC;
    gemm_tile(xb + (t & 1) * 256, 512, wf + (t & 1) * 256, 512, 256, (t >> 1) * 128, (t & 1) * 128, smem, epi_f);
  }
}

DI void phase9(const Params& p, int l) {
  const int tid = tid_(), lane = tid & 63, wid = tid >> 6;
  u16* cat = (u16*)(p.ws + O_H);
  const float* of = (const float*)(p.ws + O_OF);
  const float* ob = (const float*)(p.ws + O_OB);
  const u16* ubf = (const u16*)(p.ws + O_UBF);
  const u16* omla = (const u16*)(p.ws + O_OMLA);
  const u16* ofn = (const u16*)(p.ws + O_OFN);
  for (int rb = bid_(); rb < T / 4; rb += gridDim.x) {
    int row = rb * 4 + wid;
    u32x4 la_, lb_, lm_, lgh_, lgm0_, lgm1_, lgf_; f32x2_t lg_, lf_;
    GLOAD16(la_, of + (size_t)row * 256 + lane * 4);
    GLOAD16(lb_, ob + (size_t)row * 256 + lane * 4);
    GLOAD8(lg_, ubf + (size_t)row * 1280 + 1024 + lane * 4);
    GLOAD16(lm_, omla + (size_t)row * 512 + lane * 8);
    GLOAD8(lf_, ofn + (size_t)row * 256 + lane * 4);
    GLOAD16(lgh_, p.hgrn_norm_g + l * 64 + (lane & 15) * 4);
    GLOAD16(lgm0_, p.mla_out_norm_g + l * 512 + lane * 8);
    GLOAD16(lgm1_, p.mla_out_norm_g + l * 512 + lane * 8 + 4);
    GLOAD16(lgf_, p.fnet_norm_g + l * 256 + lane * 4);
    asm volatile("s_waitcnt vmcnt(0)" : "+v"(la_), "+v"(lb_), "+v"(lg_), "+v"(lm_), "+v"(lf_), "+v"(lgh_), "+v"(lgm0_), "+v"(lgm1_), "+v"(lgf_) :: "memory");
    {
      float4 a = make_float4(__uint_as_float(la_[0]), __uint_as_float(la_[1]), __uint_as_float(la_[2]), __uint_as_float(la_[3]));
      float4 b = make_float4(__uint_as_float(lb_[0]), __uint_as_float(lb_[1]), __uint_as_float(lb_[2]), __uint_as_float(lb_[3]));
      float4 o = make_float4(a.x + b.x, a.y + b.y, a.z + b.z, a.w + b.w);
      float ss = o.x * o.x + o.y * o.y + o.z * o.z + o.w * o.w;
      ss += __shfl_xor(ss, 1); ss += __shfl_xor(ss, 2); ss += __shfl_xor(ss, 4); ss += __shfl_xor(ss, 8);
      float rstd = rsqrtf(ss * (1.f / 64.f) + EPS);
      float4 g = make_float4(__uint_as_float(lgh_[0]), __uint_as_float(lgh_[1]), __uint_as_float(lgh_[2]), __uint_as_float(lgh_[3]));
      uint2 gr = make_uint2(__float_as_uint(lg_[0]), __float_as_uint(lg_[1]));
      float g0 = __uint_as_float(gr.x << 16), g1 = __uint_as_float(gr.x & 0xffff0000u);
      float g2 = __uint_as_float(gr.y << 16), g3 = __uint_as_float(gr.y & 0xffff0000u);
      float r0 = o.x * rstd * g.x * (g0 * sigmoidf_(g0));
      float r1 = o.y * rstd * g.y * (g1 * sigmoidf_(g1));
      float r2 = o.z * rstd * g.z * (g2 * sigmoidf_(g2));
      float r3 = o.w * rstd * g.w * (g3 * sigmoidf_(g3));
      *(uint2*)(cat + (size_t)row * DM + lane * 4) = make_uint2(pack2(r0, r1), pack2(r2, r3));
    }
    {
      uint4 raw = make_uint4(lm_[0], lm_[1], lm_[2], lm_[3]);
      unsigned uu[4] = {raw.x, raw.y, raw.z, raw.w};
      float v[8]; float ss = 0.f;
#pragma unroll
      for (int j = 0; j < 4; ++j) { v[2 * j] = __uint_as_float(uu[j] << 16); v[2 * j + 1] = __uint_as_float(uu[j] & 0xffff0000u); }
#pragma unroll
      for (int j = 0; j < 8; ++j) ss += v[j] * v[j];
      ss = wave_sum(ss);
      float rstd = rsqrtf(ss * (1.f / 512.f) + EPS);
      const float g[8] = {__uint_as_float(lgm0_[0]), __uint_as_float(lgm0_[1]), __uint_as_float(lgm0_[2]), __uint_as_float(lgm0_[3]), __uint_as_float(lgm1_[0]), __uint_as_float(lgm1_[1]), __uint_as_float(lgm1_[2]), __uint_as_float(lgm1_[3])};
      unsigned pk[4];
#pragma unroll
      for (int j = 0; j < 4; ++j) pk[j] = pack2(v[2 * j] * rstd * g[2 * j], v[2 * j + 1] * rstd * g[2 * j + 1]);
      *(uint4*)(cat + (size_t)row * DM + 256 + lane * 8) = make_uint4(pk[0], pk[1], pk[2], pk[3]);
    }
    {
      uint2 raw = make_uint2(__float_as_uint(lf_[0]), __float_as_uint(lf_[1]));
      float v0 = __uint_as_float(raw.x << 16), v1 = __uint_as_float(raw.x & 0xffff0000u);
      float v2 = __uint_as_float(raw.y << 16), v3 = __uint_as_float(raw.y & 0xffff0000u);
      float ss = wave_sum(v0 * v0 + v1 * v1 + v2 * v2 + v3 * v3);
      float rstd = rsqrtf(ss * (1.f / 256.f) + EPS);
      float4 g = make_float4(__uint_as_float(lgf_[0]), __uint_as_float(lgf_[1]), __uint_as_float(lgf_[2]), __uint_as_float(lgf_[3]));
      *(uint2*)(cat + (size_t)row * DM + 768 + lane * 4) =
          make_uint2(pack2(v0 * rstd * g.x, v1 * rstd * g.y), pack2(v2 * rstd * g.z, v3 * rstd * g.w));
    }
  }
}


#define XB_TMO      128
#define XB_XCNT(j)  (256  + 64 * (j))
#define XB_XSUB(j)  (1280 + 64 * (j))
#define XB_XGEN(j)  (2304 + 64 * (j))
#define XB_TOP      3328
#define XB_TOPGEN   3392
#define XCD_BAR_WORDS 3456
#define XB_SPIN_CAP (1u << 22)
DI unsigned xb_ld(unsigned* p) { return __hip_atomic_load(p, __ATOMIC_RELAXED, __HIP_MEMORY_SCOPE_AGENT); }
DI unsigned xb_add(unsigned* p, unsigned v) { return __hip_atomic_fetch_add(p, v, __ATOMIC_RELAXED, __HIP_MEMORY_SCOPE_AGENT); }
DI unsigned xb_xcc_id() { return (unsigned)__builtin_amdgcn_s_getreg((3 << 11) | 20) & 0xFu; }
#define XB_SPIN(cond, bar) do { unsigned _sp = 0; while (cond) { __builtin_amdgcn_s_sleep(1); \
    if ((++_sp & 255u) == 0u) { if (xb_ld(&(bar)[XB_TMO])) break; if (_sp > XB_SPIN_CAP) { atomicAdd(&(bar)[XB_TMO], 1u); break; } } } } while (0)
struct XcdBarrier { unsigned* bar; unsigned x, nloc, nx; };
DI void xcd_barrier_complete(unsigned* bar, unsigned x, unsigned& nloc, unsigned& nx) {
  const unsigned G = gridDim.x;
  unsigned sum, cnt, mine, sp = 0u;
  for (;;) {
    sum = 0u; cnt = 0u; mine = 0u;
#pragma unroll
    for (unsigned j = 0; j < 16; ++j) { const unsigned c = xb_ld(&bar[XB_XCNT(j)]); sum += c; cnt += (c > 0u) ? 1u : 0u; mine = (j == x) ? c : mine; }
    if (sum == G) break;
    __builtin_amdgcn_s_sleep(1);
    if ((++sp & 255u) == 0u) { if (xb_ld(&bar[XB_TMO])) break; if (sp > XB_SPIN_CAP) { atomicAdd(&bar[XB_TMO], 1u); break; } }
  }
  nloc = mine > 0u ? mine : 1u; nx = cnt > 0u ? cnt : 1u;
}
DI void xcd_barrier(XcdBarrier& b) {
  asm volatile("s_waitcnt vmcnt(0)" ::: "memory");
  __syncthreads();
  if (threadIdx.x == 0) {
    unsigned* bar = b.bar;
    __builtin_amdgcn_s_waitcnt(0);
    if (b.nloc == 0u) xcd_barrier_complete(bar, b.x, b.nloc, b.nx);
    const unsigned nloc = b.nloc, nx = b.nx;
    const unsigned old = xb_add(&bar[XB_XSUB(b.x)], 1u);
    const unsigned gen = old / nloc;
    if (old + 1u == (gen + 1u) * nloc) {
      __builtin_amdgcn_fence(__ATOMIC_RELEASE, "agent");
      asm volatile("s_waitcnt vmcnt(0)" ::: "memory");
      const unsigned og = xb_add(&bar[XB_TOP], 1u);
      const unsigned tg = og / nx;
      if (og + 1u == (tg + 1u) * nx) xb_add(&bar[XB_TOPGEN], 1u);
      else XB_SPIN(xb_ld(&bar[XB_TOPGEN]) == tg, bar);
      __builtin_amdgcn_fence(__ATOMIC_ACQUIRE, "agent");
      xb_add(&bar[XB_XGEN(b.x)], 1u);
      asm volatile("s_waitcnt vmcnt(0)" ::: "memory");
    } else {
      XB_SPIN(xb_ld(&bar[XB_XGEN(b.x)]) == gen, bar);
      __builtin_amdgcn_fence(__ATOMIC_ACQUIRE, "agent");
      asm volatile("s_waitcnt vmcnt(0)" ::: "memory");
    }
  }
  __syncthreads();
}

constexpr int NPHASE = 1 + 2 * 13;
DI void run_phase(const Params& p, int ph, char* smem, int shint = -1) {
  if (ph == 0) { phase_prep(p, smem); return; }
  int l = (ph - 1) / 13, s = shint >= 0 ? shint : (ph - 1) % 13;
  switch (s) {
    case 0: phase_norm(p, l, 0, l == 0); break;
    case 1: phase_ffn_gu(p, l, 0, smem); break;
    case 2: phase_gemm_resid(p, (const u16*)(p.ws + O_BIG), DFF, (const u16*)(p.ws + O_WDN) + (size_t)(l * 2 + 0) * DM * DFF, l, 2, 0.5f, smem); break;
    case 3: phase_norm(p, l, 1, false); break;
    case 4: phase_win(p, l, smem); break;
    case 5: phase6(p, l, smem); break;
    case 6: phase7(p, l, smem); break;
    case 7: phase8(p, l, smem); break;
    case 8: phase9(p, l); break;
    case 9: phase_gemm_resid(p, (const u16*)(p.ws + O_H), DM, (const u16*)(p.ws + O_WO) + (size_t)l * DM * DM, l, 5, 1.0f, smem); break;
    case 10: phase_norm(p, l, 2, false); break;
    case 11: phase_ffn_gu(p, l, 1, smem); break;
    case 12: phase_gemm_resid(p, (const u16*)(p.ws + O_BIG), DFF, (const u16*)(p.ws + O_WDN) + (size_t)(l * 2 + 1) * DM * DFF, l, 8, 0.5f, smem); break;
  }
}

#if MEGA
__global__ void __launch_bounds__(256, 2) mega_kernel(Params p, int ph0, int ph1) {
  __shared__ __attribute__((aligned(16))) char smem[SMEM_BYTES];
  cg::grid_group grid = cg::this_grid();
  XcdBarrier xb;
  xb.bar = (unsigned*)(p.ws + O_BAR); xb.x = xb_xcc_id(); xb.nloc = 0u; xb.nx = 0u;
  if (ph1 - ph0 > 1 && threadIdx.x == 0) (void)xb_add(&xb.bar[XB_XCNT(xb.x)], 1u);
  for (int ph = ph0; ph < ph1; ++ph) {
    run_phase(p, ph, smem);
#ifdef PROBE_DUP
    if (ph > 0 && ((PROBE_DUP >> ((ph - 1) % 13)) & 1)) { xcd_barrier(xb); run_phase(p, ph, smem); }
#endif
    if (ph + 1 < ph1) { if (p.ws == nullptr) grid.sync(); else xcd_barrier(xb); }
  }
}
#else
template <int S>
__global__ void __launch_bounds__(256, 2) phase_kernel(Params p, int l) {
  __shared__ __attribute__((aligned(16))) char smem[SMEM_BYTES];
  if (S < 0) phase_prep(p, smem); else run_phase(p, 1 + l * 13 + S, smem, S);
}
#endif

extern "C" void kernel_launch(void* const* d_in, const int* in_sizes, int n_in, void* d_out, int out_size, void* d_ws,
                              size_t ws_size, hipStream_t stream) {
  Params p{};
  const float** pp = (const float**)&p;
  for (int i = 0; i < 24; ++i) pp[i] = (const float*)d_in[i];
  p.out = (float*)d_out;
  p.ws = (char*)d_ws;
  if (ws_size < WS_TOTAL) { fprintf(stderr, "workspace too small: %zu < %zu\n", ws_size, (size_t)WS_TOTAL); return; }
#if MEGA
  static int grid_blocks = 0;
  if (!grid_blocks) {
    int dev = 0, cus = 0, per_cu = 0;
    hipGetDevice(&dev);
    hipDeviceGetAttribute(&cus, hipDeviceAttributeMultiprocessorCount, dev);
    hipOccupancyMaxActiveBlocksPerMultiprocessor(&per_cu, mega_kernel, 256, 0);
    (void)per_cu;
    grid_blocks = cus * 2;
  }
  hipMemsetAsync(p.ws + O_BAR, 0, XCD_BAR_WORDS * 4, stream);
#if MEGA == 2
  for (int ph = 0; ph < NPHASE; ++ph) mega_kernel<<<grid_blocks, 256, 0, stream>>>(p, ph, ph + 1);
#else
  int ph0 = 0, ph1 = NPHASE;
  void* args[] = {&p, &ph0, &ph1};
  hipError_t e = hipLaunchCooperativeKernel((void*)mega_kernel, dim3(grid_blocks), dim3(256), args, 0, stream);
  if (e != hipSuccess) fprintf(stderr, "cooperative launch failed: %s (grid %d)\n", hipGetErrorString(e), grid_blocks);
#endif
#else
  phase_kernel<-1><<<512, 256, 0, stream>>>(p, 0);
  for (int l = 0; l < 2; ++l) {
    phase_kernel<0><<<512, 256, 0, stream>>>(p, l);
    phase_kernel<1><<<512, 256, 0, stream>>>(p, l);
    phase_kernel<2><<<512, 256, 0, stream>>>(p, l);
    phase_kernel<3><<<512, 256, 0, stream>>>(p, l);
    phase_kernel<4><<<512, 256, 0, stream>>>(p, l);
    phase_kernel<5><<<512, 256, 0, stream>>>(p, l);
    phase_kernel<6><<<512, 256, 0, stream>>>(p, l);
    phase_kernel<7><<<512, 256, 0, stream>>>(p, l);
    phase_kernel<8><<<512, 256, 0, stream>>>(p, l);
    phase_kernel<9><<<512, 256, 0, stream>>>(p, l);
    phase_kernel<10><<<512, 256, 0, stream>>>(p, l);
    phase_kernel<11><<<512, 256, 0, stream>>>(p, l);
    phase_kernel<12><<<512, 256, 0, stream>>>(p, l);
  }
#endif
}
```

```cpp
#include <hip/hip_runtime.h>
#include <hip/hip_cooperative_groups.h>
#include <stdint.h>
#include <stdio.h>
namespace cg = cooperative_groups;

#ifndef MEGA
#define MEGA 1
#endif

typedef unsigned short u16;
typedef __attribute__((ext_vector_type(8))) short bf16x8;
typedef __attribute__((ext_vector_type(4))) float f32x4;
typedef __attribute__((ext_vector_type(16))) float f32x16;
#define DI __device__ __forceinline__

constexpr int T = 16384, TC = 8192, DM = 1024, DFF = 2816, NGU = 5632, NIN = 2208, NINP = 2304;
constexpr int TK = 17408;
constexpr float EPS = 1e-6f;
constexpr int SMEM_BYTES = 65536;

constexpr size_t al(size_t x) { return (x + 255) & ~(size_t)255; }
constexpr size_t O_WGU = 0;
constexpr size_t O_WDN = O_WGU + al((size_t)4 * NGU * DM * 2);
constexpr size_t O_WIN = O_WDN + al((size_t)4 * DM * DFF * 2);
constexpr size_t O_WQ = O_WIN + al((size_t)2 * NINP * DM * 2);
constexpr size_t O_WKV = O_WQ + al((size_t)2 * 768 * 384 * 2);
constexpr size_t O_WO = O_WKV + al((size_t)2 * 1024 * 256 * 2);
constexpr size_t O_WF = O_WO + al((size_t)2 * 1024 * 1024 * 2);
constexpr size_t O_MOD = O_WF + al((size_t)2 * 256 * 512 * 2);
constexpr size_t O_TAB = O_MOD + al((size_t)2 * 3 * 9216 * 4);
constexpr int TAB_W64 = 4944, TAB_W16 = 4944 + 4096, TAB_N = 4944 + 4096 + 256;
constexpr size_t O_H = O_TAB + al((size_t)TAB_N * 8);
constexpr size_t O_BIG = O_H + al((size_t)T * DM * 2);
constexpr size_t SZ_BIG = al((size_t)T * 1280 * 2) + al((size_t)T * 928 * 4);
constexpr size_t O_UBF = O_BIG;
constexpr size_t O_UM = O_BIG + al((size_t)T * 1280 * 2);
constexpr size_t O_C1 = O_BIG + SZ_BIG;
constexpr size_t O_CQN = O_C1;
constexpr size_t O_CKVN = O_CQN + al((size_t)T * 384 * 2);
constexpr size_t O_YFFT = O_CKVN + al((size_t)TK * 256 * 2);
constexpr size_t E_C1A = O_YFFT + al((size_t)T * 256 * 8);
constexpr size_t O_OMLA = O_C1;
constexpr size_t O_OF = O_OMLA + al((size_t)T * 512 * 2);
constexpr size_t O_OB = O_OF + al((size_t)T * 256 * 4);
constexpr size_t O_OFN = O_OB + al((size_t)T * 256 * 4);
constexpr size_t E_C1B = O_OFN + al((size_t)T * 256 * 2);
constexpr size_t O_C2 = (E_C1A > E_C1B ? E_C1A : E_C1B);
constexpr size_t O_KBUF = O_C2;
constexpr size_t O_VT = O_KBUF + al((size_t)TK * 8 * 96 * 2);
constexpr size_t O_XBUF = O_VT + al((size_t)TK * 8 * 64 * 2);
constexpr size_t O_SLOC = O_XBUF + al((size_t)T * 512 * 2);
constexpr size_t O_DTOT = O_SLOC + al((size_t)1024 * 4096 * 4);
constexpr size_t O_KRR = O_DTOT + al((size_t)1024 * 64 * 4);
constexpr size_t O_KRSS = O_KRR + al((size_t)TK * 32 * 4);
constexpr size_t O_BAR = O_KRSS + al((size_t)TK * 4);
constexpr size_t O_SIN = O_H + (size_t)T * 768 * 2;
static_assert((size_t)T * 768 * 2 + (size_t)512 * 4096 * 4 <= (size_t)T * DM * 2, "sin fits behind qraw");
constexpr size_t WS_TOTAL = O_BAR + al((size_t)3456 * 4);
static_assert(WS_TOTAL <= (size_t)369098752, "workspace too large");
static_assert((size_t)T * DFF * 2 <= SZ_BIG, "act fits");
static_assert((size_t)T * 768 * 2 <= (size_t)T * DM * 2, "qraw fits in h");

constexpr size_t OUT_X = 0;
constexpr size_t OUT_CKV = (size_t)T * DM;
constexpr size_t OUT_KR = OUT_CKV + (size_t)32 * 2 * 256 * 256;
constexpr size_t OUT_ST = OUT_KR + (size_t)32 * 2 * 256 * 32;

struct Params {
  const float *x_prompt, *x_sample, *cache_ckv, *cache_krope, *state_hgrn, *c, *c_ctx, *ada_w, *ada_b, *norm_g;
  const float *ffn_w_gu, *ffn_w_down, *w_in, *hgrn_lb, *hgrn_norm_g, *mla_q_norm_g, *mla_w_q_up, *mla_kv_norm_g;
  const float *mla_w_kv_up, *mla_qk_norm_g, *mla_out_norm_g, *fnet_w, *fnet_norm_g, *w_out;
  float* out;
  char* ws;
};

typedef unsigned u32x4 __attribute__((ext_vector_type(4)));
#define GLOAD16(dst, ptr) asm volatile("global_load_dwordx4 %0, %1, off" : "=v"(dst) : "v"(ptr) : "memory")
#define VMWAIT0() asm volatile("s_waitcnt vmcnt(0)" ::: "memory")
#define GLOAD4(dst, ptr) asm volatile("global_load_dword %0, %1, off" : "=v"(dst) : "v"(ptr) : "memory")
#define GLOAD8(dst, ptr) asm volatile("global_load_dwordx2 %0, %1, off" : "=v"(dst) : "v"(ptr) : "memory")
DI int tid_() { int t = threadIdx.x; asm volatile("" : "+v"(t)); return t; }
DI int bid_() { int t = blockIdx.x; asm volatile("" : "+s"(t)); return t; }
DI u16 f2bf(float x) { __bf16 h = (__bf16)x; return __builtin_bit_cast(u16, h); }
DI float bf2f(u16 h) { return __uint_as_float(((unsigned)h) << 16); }
typedef __bf16 bf16x2_t __attribute__((ext_vector_type(2)));
typedef float f32x2_t __attribute__((ext_vector_type(2)));
DI unsigned pack2(float a, float b) { f32x2_t v = {a, b}; bf16x2_t r = __builtin_convertvector(v, bf16x2_t); return __builtin_bit_cast(unsigned, r); }
DI float wave_sum(float v) {
#pragma unroll
  for (int o = 32; o > 0; o >>= 1) v += __shfl_xor(v, o);
  return v;
}
DI int cond_of(int row) { return row < TC ? 0 : 1 + ((row - TC) >> 12); }
DI float sigmoidf_(float x) { return __builtin_amdgcn_rcpf(1.f + __expf(-x)); }

template <class Epi>
DI void gemm_tile(const u16* __restrict__ A, int lda, const u16* __restrict__ Bt, int ldb, int K, int m0, int n0,
                  char* smem, Epi epi) {
  const int tid = tid_(), lane = tid & 63, wid = tid >> 6, wm = wid >> 1, wn = wid & 1;
  const int l15 = lane & 15, quad = lane >> 4;
  f32x4 acc[4][4];
#pragma unroll
  for (int i = 0; i < 4; ++i)
#pragma unroll
    for (int j = 0; j < 4; ++j) acc[i][j] = (f32x4){0.f, 0.f, 0.f, 0.f};
  const int lrow = tid >> 3;
  const int gch = (tid & 7) ^ ((tid >> 4) & 7);
  const u16* ga = A + (size_t)(m0 + lrow) * lda + gch * 8;
  const u16* gb = Bt + (size_t)(n0 + lrow) * ldb + gch * 8;
  const int nk = K >> 6;
#define GEMM_GLDS(KT, BUF)                                                                                     \
  {                                                                                                            \
    char* d_ = smem + (BUF) * 32768 + tid * 16;                                                                \
    _Pragma("unroll") for (int i = 0; i < 4; ++i) {                                                            \
      __builtin_amdgcn_global_load_lds((const unsigned*)(ga + (size_t)i * 32 * lda + (KT) * 64),               \
                                       (unsigned*)(d_ + i * 4096), 16, 0, 0);                                  \
      __builtin_amdgcn_global_load_lds((const unsigned*)(gb + (size_t)i * 32 * ldb + (KT) * 64),               \
                                       (unsigned*)(d_ + 16384 + i * 4096), 16, 0, 0);                          \
    }                                                                                                          \
  }
  GEMM_GLDS(0, 0)
  asm volatile("s_waitcnt vmcnt(0)" ::: "memory");
  __builtin_amdgcn_s_barrier(); asm volatile("" ::: "memory");
  const unsigned lds0 = (unsigned)(size_t)smem;
  const int sw_ = (l15 >> 1) & 7;
  const unsigned ab0 = lds0 + (wm * 64 + l15) * 128 + ((quad ^ sw_) << 4);
  const unsigned ab1 = lds0 + (wm * 64 + l15) * 128 + (((4 + quad) ^ sw_) << 4);
  const unsigned bb0 = lds0 + 16384 + (wn * 64 + l15) * 128 + ((quad ^ sw_) << 4);
  const unsigned bb1 = lds0 + 16384 + (wn * 64 + l15) * 128 + (((4 + quad) ^ sw_) << 4);
#define DSR(dst, addr, OFF) asm volatile("ds_read_b128 %0, %1 offset:" #OFF : "=v"(dst) : "v"(addr) : "memory")
#define GEMM_MMA(AF, BF)                                                                     \
  _Pragma("unroll") for (int mi = 0; mi < 4; ++mi)                                           \
    _Pragma("unroll") for (int ni = 0; ni < 4; ++ni)                                         \
      acc[mi][ni] = __builtin_amdgcn_mfma_f32_16x16x32_bf16(AF[mi], BF[ni], acc[mi][ni], 0, 0, 0);
#define GEMM_WAIT(N, AF, BF)                                                                 \
  asm volatile("s_waitcnt lgkmcnt(" #N ")" : "+v"(AF[0]), "+v"(AF[1]), "+v"(AF[2]), "+v"(AF[3]), "+v"(BF[0]), "+v"(BF[1]), "+v"(BF[2]), "+v"(BF[3]) :: "memory");
#define GEMM_COMPUTE(O0, O1, O2, O3)                                                         \
  {                                                                                          \
    bf16x8 a0[4], b0[4], a1[4], b1[4];                                                       \
    DSR(a0[0], ab0, O0); DSR(a0[1], ab0, O1); DSR(a0[2], ab0, O2); DSR(a0[3], ab0, O3);      \
    DSR(b0[0], bb0, O0); DSR(b0[1], bb0, O1); DSR(b0[2], bb0, O2); DSR(b0[3], bb0, O3);      \
    DSR(a1[0], ab1, O0); DSR(a1[1], ab1, O1); DSR(a1[2], ab1, O2); DSR(a1[3], ab1, O3);      \
    DSR(b1[0], bb1, O0); DSR(b1[1], bb1, O1); DSR(b1[2], bb1, O2); DSR(b1[3], bb1, O3);      \
    GEMM_WAIT(8, a0, b0)                                                                     \
    __builtin_amdgcn_s_setprio(1);                                                           \
    GEMM_MMA(a0, b0)                                                                         \
    __builtin_amdgcn_sched_barrier(0);                                                       \
    GEMM_WAIT(0, a1, b1)                                                                     \
    GEMM_MMA(a1, b1)                                                                         \
    __builtin_amdgcn_s_setprio(0);                                                           \
    __builtin_amdgcn_sched_barrier(0);                                                       \
  }
  for (int kt = 0; kt < nk; kt += 2) {
    GEMM_GLDS(kt + 1, 1)
    GEMM_COMPUTE(0, 2048, 4096, 6144)
    asm volatile("s_waitcnt vmcnt(0)" ::: "memory");
    __builtin_amdgcn_s_barrier(); asm volatile("" ::: "memory");
    if (kt + 2 < nk) GEMM_GLDS(kt + 2, 0)
    GEMM_COMPUTE(32768, 34816, 36864, 38912)
    asm volatile("s_waitcnt vmcnt(0)" ::: "memory");
    __builtin_amdgcn_s_barrier(); asm volatile("" ::: "memory");
  }
  epi(acc, m0 + wm * 64, n0 + wn * 64, lane);
}

DI void tile_mn(int t, int nM, int nN, int& mt, int& nt) {
  int per = 16 * nN;
  int g = t / per, r = t - g * per;
  int gm = nM - g * 16; if (gm > 16) gm = 16;
  mt = g * 16 + (r % gm);
  nt = r / gm;
}

DI void transpose_tile(const float* __restrict__ src, int K, int N, u16* __restrict__ dst, int kt, int nt, int mode,
                       float* tile) {
  const int tid = tid_();
  const int k0 = kt * 64, n0 = nt * 64;
  {
    const int n = tid & 63;
    const bool inb = n0 + n < N;
    const float* sp = src + (size_t)(k0 + (tid >> 6)) * N + (inb ? n0 + n : 0);
    float tv[16];
#pragma unroll
    for (int i = 0; i < 16; ++i) GLOAD4(tv[i], sp + (size_t)(i * 4) * N);
    asm volatile("s_waitcnt vmcnt(0)" : "+v"(tv[0]), "+v"(tv[1]), "+v"(tv[2]), "+v"(tv[3]), "+v"(tv[4]), "+v"(tv[5]), "+v"(tv[6]), "+v"(tv[7]),
                 "+v"(tv[8]), "+v"(tv[9]), "+v"(tv[10]), "+v"(tv[11]), "+v"(tv[12]), "+v"(tv[13]), "+v"(tv[14]), "+v"(tv[15]) :: "memory");
#pragma unroll
    for (int i = 0; i < 16; ++i) tile[(i * 4 + (tid >> 6)) * 65 + n] = inb ? tv[i] : 0.f;
  }
  __syncthreads();
  const int nl = tid >> 2, ks = (tid & 3) * 16;
  int n = n0 + nl, nd = n;
  if (mode == 1) {
    if (n < DFF) nd = (n >> 4) * 32 + (n & 15);
    else { int c = n - DFF; nd = (c >> 4) * 32 + 16 + (c & 15); }
  }
  unsigned pk[8];
#pragma unroll
  for (int j = 0; j < 8; ++j) pk[j] = pack2(tile[(ks + 2 * j) * 65 + nl], tile[(ks + 2 * j + 1) * 65 + nl]);
  uint4* d = (uint4*)(dst + (size_t)nd * K + k0 + ks);
  d[0] = make_uint4(pk[0], pk[1], pk[2], pk[3]);
  d[1] = make_uint4(pk[4], pk[5], pk[6], pk[7]);
  __syncthreads();
}

constexpr int NT_WGU = 4 * 16 * 88, NT_WDN = 4 * 44 * 16, NT_WIN = 2 * 16 * 36, NT_WQ = 2 * 6 * 12, NT_WKV = 2 * 4 * 16,
              NT_WO = 2 * 16 * 16;
constexpr int NT_TR = NT_WGU + NT_WDN + NT_WIN + NT_WQ + NT_WKV + NT_WO;
constexpr int NT_WF = 1024, NT_MOD = 288, NT_TAB = 1;
constexpr int NT_PREP = NT_TR + NT_WF + NT_MOD + NT_TAB;

DI void phase_prep(const Params& p, char* smem) {
  const int tid = tid_();
  float* fs = (float*)smem;
  for (int it = bid_(); it < NT_PREP; it += gridDim.x) {
    int t = it;
    if (t < NT_TR) {
      if (t < NT_WGU) {
        int m = t / (16 * 88), r = t % (16 * 88);
        transpose_tile(p.ffn_w_gu + (size_t)m * DM * NGU, DM, NGU, (u16*)(p.ws + O_WGU) + (size_t)m * NGU * DM, r / 88,
                       r % 88, 1, fs);
        continue;
      }
      t -= NT_WGU;
      if (t < NT_WDN) {
        int m = t / (44 * 16), r = t % (44 * 16);
        transpose_tile(p.ffn_w_down + (size_t)m * DFF * DM, DFF, DM, (u16*)(p.ws + O_WDN) + (size_t)m * DM * DFF, r / 16,
                       r % 16, 0, fs);
        continue;
      }
      t -= NT_WDN;
      if (t < NT_WIN) {
        int m = t / (16 * 36), r = t % (16 * 36);
        transpose_tile(p.w_in + (size_t)m * DM * NIN, DM, NIN, (u16*)(p.ws + O_WIN) + (size_t)m * NINP * DM, r / 36,
                       r % 36, 0, fs);
        continue;
      }
      t -= NT_WIN;
      if (t < NT_WQ) {
        int m = t / 72, r = t % 72;
        transpose_tile(p.mla_w_q_up + (size_t)m * 384 * 768, 384, 768, (u16*)(p.ws + O_WQ) + (size_t)m * 768 * 384, r / 12,
                       r % 12, 0, fs);
        continue;
      }
      t -= NT_WQ;
      if (t < NT_WKV) {
        int m = t / 64, r = t % 64;
        transpose_tile(p.mla_w_kv_up + (size_t)m * 256 * 1024, 256, 1024, (u16*)(p.ws + O_WKV) + (size_t)m * 1024 * 256,
                       r / 16, r % 16, 0, fs);
        continue;
      }
      t -= NT_WKV;
      {
        int m = t / 256, r = t % 256;
        transpose_tile(p.w_out + (size_t)m * DM * DM, DM, DM, (u16*)(p.ws + O_WO) + (size_t)m * DM * DM, r / 16, r % 16, 0,
                       fs);
        continue;
      }
    }
    t -= NT_TR;
    if (t < NT_WF) {
      int e = t * 256 + tid;
      int l = e >> 17, r = e & 131071;
      int nrow = r >> 9, kcol = r & 511;
      int g = nrow >> 6, d = nrow & 63, g2 = kcol >> 7, part = (kcol >> 6) & 1, c = kcol & 63;
      float v = 0.f;
      if (g == g2) {
        const float* fw = p.fnet_w + ((size_t)(l * 4 + g) * 64) * 64 + d;
        float fv[64];
#pragma unroll
        for (int m = 0; m < 64; ++m) GLOAD4(fv[m], fw + m * 64);
#pragma unroll
        for (int m = 0; m < 64; m += 8)
          asm volatile("s_waitcnt vmcnt(0)" : "+v"(fv[m]), "+v"(fv[m + 1]), "+v"(fv[m + 2]), "+v"(fv[m + 3]), "+v"(fv[m + 4]), "+v"(fv[m + 5]), "+v"(fv[m + 6]), "+v"(fv[m + 7]) :: "memory");
#pragma unroll
        for (int m = 0; m < 64; ++m) {
          int idx = (m * c) & 63;
          float ang = (float)idx * (6.283185307179586f / 64.f);
          float w = part ? __sinf(ang) : __cosf(ang);
          v += w * fv[m];
        }
      }
      ((u16*)(p.ws + O_WF))[e] = f2bf(v);
      continue;
    }
    t -= NT_WF;
    if (t < NT_MOD) {
      int l = t / 144, cb = t % 144;
      float* sc = fs;
      float* red = fs + 3072;
      for (int i = tid; i < 3072; i += 256) {
        int cnd = i >> 10, k = i & 1023;
        float v = cnd == 0 ? p.c_ctx[k] : p.c[(cnd - 1) * 1024 + k];
        sc[i] = v * sigmoidf_(v);
      }
      __syncthreads();
      int kq = tid >> 4, cq = tid & 15;
      float a[3][4];
#pragma unroll
      for (int i = 0; i < 3; ++i)
#pragma unroll
        for (int j = 0; j < 4; ++j) a[i][j] = 0.f;
      const float* wbase = p.ada_w + (size_t)l * 1024 * 9216 + cb * 64 + cq * 4;
      for (int k0 = kq; k0 < 1024; k0 += 128) {
        u32x4 wv[8];
#pragma unroll
        for (int j = 0; j < 8; ++j) GLOAD16(wv[j], wbase + (size_t)(k0 + 16 * j) * 9216);
        asm volatile("s_waitcnt vmcnt(0)" : "+v"(wv[0]), "+v"(wv[1]), "+v"(wv[2]), "+v"(wv[3]), "+v"(wv[4]), "+v"(wv[5]), "+v"(wv[6]), "+v"(wv[7]) :: "memory");
#pragma unroll
        for (int j = 0; j < 8; ++j) {
          const int k = k0 + 16 * j;
          const float wx = __uint_as_float(wv[j][0]), wy = __uint_as_float(wv[j][1]), wz = __uint_as_float(wv[j][2]), ww = __uint_as_float(wv[j][3]);
#pragma unroll
          for (int i = 0; i < 3; ++i) {
            float s = sc[i * 1024 + k];
            a[i][0] += s * wx; a[i][1] += s * wy; a[i][2] += s * wz; a[i][3] += s * ww;
          }
        }
      }
#pragma unroll
      for (int i = 0; i < 3; ++i)
#pragma unroll
        for (int j = 0; j < 4; ++j) red[(kq * 3 + i) * 64 + cq * 4 + j] = a[i][j];
      __syncthreads();
      if (tid < 192) {
        int i = tid >> 6, col = tid & 63;
        float s = 0.f;
        for (int q = 0; q < 16; ++q) s += red[(q * 3 + i) * 64 + col];
        int cc = cb * 64 + col;
        ((float*)(p.ws + O_MOD))[(size_t)(l * 3 + i) * 9216 + cc] = s + p.ada_b[l * 9216 + cc];
      }
      __syncthreads();
      continue;
    }
    t -= NT_MOD;
    {
      float2* tab = (float2*)(p.ws + O_TAB);
      for (int i = tid; i < TAB_N; i += 256) {
        int n, L;
        float ang;
        if (i < 4432) {
          if (i < 16) { n = i; L = 16; }
          else if (i < 80) { n = i - 16; L = 64; }
          else if (i < 336) { n = i - 80; L = 256; }
          else { n = i - 336; L = 4096; }
          ang = (float)n * (6.283185307179586f / (float)L);
        } else if (i < TAB_W64) {
          int e = i - 4432;
          float freq = exp2f(-(float)(e & 7) * (13.287712379549449f / 8.f));
          ang = (float)(e >> 3) * freq;
        } else if (i < TAB_W16) {
          int e = i - TAB_W64;
          ang = (float)(((e >> 6) * (e & 63)) & 63) * (6.283185307179586f / 64.f);
        } else {
          int e = i - TAB_W16;
          ang = (float)(((e >> 4) * (e & 15)) & 15) * (6.283185307179586f / 16.f);
        }
        tab[i] = make_float2(cosf(ang), sinf(ang));
      }
    }
  }
}

DI void phase_norm(const Params& p, int l, int idx, bool first) {
  const int tid = tid_(), lane = tid & 63, wid = tid >> 6;
  const float* mod = (const float*)(p.ws + O_MOD) + (size_t)l * 3 * 9216;
  const float* g = p.norm_g + (size_t)(l * 3 + idx) * 1024;
  u16* h = (u16*)(p.ws + O_H);
  for (int rb = bid_(); rb < T / 8; rb += gridDim.x) {
    float4 v[2][4];
    float ss[2];
#pragma unroll
    for (int q = 0; q < 2; ++q) {
      const int row = rb * 8 + q * 4 + wid;
      const float* src = first ? (row < TC ? p.x_prompt + (size_t)row * DM : p.x_sample + (size_t)(row - TC) * DM)
                               : p.out + (size_t)row * DM;
#pragma unroll
      for (int i = 0; i < 4; ++i) v[q][i] = *(const float4*)(src + i * 256 + lane * 4);
    }
#pragma unroll
    for (int q = 0; q < 2; ++q) {
      float s = 0.f;
#pragma unroll
      for (int i = 0; i < 4; ++i) s += v[q][i].x * v[q][i].x + v[q][i].y * v[q][i].y + v[q][i].z * v[q][i].z + v[q][i].w * v[q][i].w;
      ss[q] = s;
    }
#pragma unroll
    for (int o = 32; o > 0; o >>= 1) { ss[0] += __shfl_xor(ss[0], o); ss[1] += __shfl_xor(ss[1], o); }
    u32x4 pg[4], psc[2][4], psh[2][4];
#pragma unroll
    for (int i = 0; i < 4; ++i) GLOAD16(pg[i], g + i * 256 + lane * 4);
#pragma unroll
    for (int q = 0; q < 2; ++q) {
      const int row = rb * 8 + q * 4 + wid;
      const float* mc = mod + (size_t)cond_of(row) * 9216;
#pragma unroll
      for (int i = 0; i < 4; ++i) {
        GLOAD16(psc[q][i], mc + (3 * idx + 1) * 1024 + i * 256 + lane * 4);
        GLOAD16(psh[q][i], mc + (3 * idx) * 1024 + i * 256 + lane * 4);
      }
    }
    asm volatile("s_waitcnt vmcnt(0)" : "+v"(pg[0]), "+v"(pg[1]), "+v"(pg[2]), "+v"(pg[3]) :: "memory");
    asm volatile("" : "+v"(psc[0][0]), "+v"(psc[0][1]), "+v"(psc[0][2]), "+v"(psc[0][3]), "+v"(psc[1][0]), "+v"(psc[1][1]), "+v"(psc[1][2]), "+v"(psc[1][3]) :: "memory");
    asm volatile("" : "+v"(psh[0][0]), "+v"(psh[0][1]), "+v"(psh[0][2]), "+v"(psh[0][3]), "+v"(psh[1][0]), "+v"(psh[1][1]), "+v"(psh[1][2]), "+v"(psh[1][3]) :: "memory");
#pragma unroll
    for (int q = 0; q < 2; ++q) {
      const int row = rb * 8 + q * 4 + wid;
      const float rstd = rsqrtf(ss[q] * (1.f / 1024.f) + EPS);
#pragma unroll
      for (int i = 0; i < 4; ++i) {
        int col = i * 256 + lane * 4;
        float a = v[q][i].x * rstd * __uint_as_float(pg[i][0]) * (1.f + __uint_as_float(psc[q][i][0])) + __uint_as_float(psh[q][i][0]);
        float b = v[q][i].y * rstd * __uint_as_float(pg[i][1]) * (1.f + __uint_as_float(psc[q][i][1])) + __uint_as_float(psh[q][i][1]);
        float c = v[q][i].z * rstd * __uint_as_float(pg[i][2]) * (1.f + __uint_as_float(psc[q][i][2])) + __uint_as_float(psh[q][i][2]);
        float d = v[q][i].w * rstd * __uint_as_float(pg[i][3]) * (1.f + __uint_as_float(psc[q][i][3])) + __uint_as_float(psh[q][i][3]);
        *(uint2*)(h + (size_t)row * DM + col) = make_uint2(pack2(a, b), pack2(c, d));
        if (first) *(float4*)(p.out + (size_t)row * DM + col) = v[q][i];
      }
    }
  }
}

DI void phase_ffn_gu(const Params& p, int l, int f, char* smem) {
  const u16* A = (const u16*)(p.ws + O_H);
  const u16* Bt = (const u16*)(p.ws + O_WGU) + (size_t)(l * 2 + f) * NGU * DM;
  u16* act = (u16*)(p.ws + O_BIG);
  auto epi = [&](f32x4 (&acc)[4][4], int mb, int nb, int lane) {
    const int l15 = lane & 15, quad = lane >> 4;
#pragma unroll
    for (int mi = 0; mi < 4; ++mi)
#pragma unroll
      for (int pq = 0; pq < 2; ++pq) {
        int c = ((nb >> 5) + pq) * 16 + l15;
#pragma unroll
        for (int j = 0; j < 4; ++j) {
          int row = mb + mi * 16 + quad * 4 + j;
          float gt = acc[mi][2 * pq][j], up = acc[mi][2 * pq + 1][j];
          act[(size_t)row * DFF + c] = f2bf(gt * sigmoidf_(gt) * up);
        }
      }
  };
  const int nM = T / 128, nN = NGU / 128;
  for (int t = bid_(); t < nM * nN; t += gridDim.x) {
    int mt, nt; tile_mn(t, nM, nN, mt, nt);
    gemm_tile(A, DM, Bt, DM, DM, mt * 128, nt * 128, smem, epi);
  }
}

DI void phase_gemm_resid(const Params& p, const u16* A, int K, const u16* Bt, int l, int gidx, float coef, char* smem) {
  const float* mod = (const float*)(p.ws + O_MOD) + (size_t)l * 3 * 9216 + (size_t)gidx * 1024;
  float* x = p.out;
  auto epi = [&](f32x4 (&acc)[4][4], int mb, int nb, int lane) {
    const int l15 = lane & 15, quad = lane >> 4;
    const float* gm = mod + (size_t)cond_of(mb) * 9216;
#pragma unroll
    for (int ni = 0; ni < 4; ++ni) {
      int col = nb + ni * 16 + l15;
      float gt = coef * gm[col];
      float* xp = x + (size_t)(mb + quad * 4) * DM + col;
      float xv[16];
#pragma unroll
      for (int mi = 0; mi < 4; ++mi)
#pragma unroll
        for (int j = 0; j < 4; ++j) GLOAD4(xv[mi * 4 + j], xp + (size_t)(mi * 16 + j) * DM);
      asm volatile("s_waitcnt vmcnt(0)" : "+v"(xv[0]), "+v"(xv[1]), "+v"(xv[2]), "+v"(xv[3]), "+v"(xv[4]), "+v"(xv[5]), "+v"(xv[6]), "+v"(xv[7]),
                   "+v"(xv[8]), "+v"(xv[9]), "+v"(xv[10]), "+v"(xv[11]), "+v"(xv[12]), "+v"(xv[13]), "+v"(xv[14]), "+v"(xv[15]) :: "memory");
#pragma unroll
      for (int mi = 0; mi < 4; ++mi)
#pragma unroll
        for (int j = 0; j < 4; ++j) xp[(size_t)(mi * 16 + j) * DM] = xv[mi * 4 + j] + gt * acc[mi][ni][j];
    }
  };
  const int nM = T / 128, nN = DM / 128;
  for (int t = bid_(); t < nM * nN; t += gridDim.x) {
    int mt, nt; tile_mn(t, nM, nN, mt, nt);
    gemm_tile(A, K, Bt, K, K, mt * 128, nt * 128, smem, epi);
  }
}

DI void phase_win(const Params& p, int l, char* smem) {
  const u16* A = (const u16*)(p.ws + O_H);
  const u16* Bt = (const u16*)(p.ws + O_WIN) + (size_t)l * NINP * DM;
  u16* ubf = (u16*)(p.ws + O_UBF);
  float* um = (float*)(p.ws + O_UM);
  auto epi = [&](f32x4 (&acc)[4][4], int mb, int nb, int lane) {
    const int l15 = lane & 15, quad = lane >> 4;
#pragma unroll
    for (int ni = 0; ni < 4; ++ni) {
      int col = nb + ni * 16 + l15;
#pragma unroll
      for (int mi = 0; mi < 4; ++mi)
#pragma unroll
        for (int j = 0; j < 4; ++j) {
          int row = mb + mi * 16 + quad * 4 + j;
          if (col < 1280) ubf[(size_t)row * 1280 + col] = f2bf(acc[mi][ni][j]);
          else if (col < NIN) um[(size_t)row * 928 + (col - 1280)] = acc[mi][ni][j];
        }
    }
  };
  const int nM = T / 128, nN = NINP / 128;
  for (int t = bid_(); t < nM * nN; t += gridDim.x) {
    int mt, nt; tile_mn(t, nM, nN, mt, nt);
    gemm_tile(A, DM, Bt, DM, DM, mt * 128, nt * 128, smem, epi);
  }
}

DI void mixprep_rows(const Params& p, int l, int item) {
  const int tid = tid_(), lane = tid & 63, wid = tid >> 6;
  int row = item * 4 + wid;
  u16* cqn = (u16*)(p.ws + O_CQN);
  u16* ckvn = (u16*)(p.ws + O_CKVN);
  float* krr = (float*)(p.ws + O_KRR);
  float* krss = (float*)(p.ws + O_KRSS);
  const float* g1 = p.mla_qk_norm_g + (size_t)(l * 2 + 1) * 96;
  if (row < T) {
    const float* um = (const float*)(p.ws + O_UM) + (size_t)row * 928;
    float lq_[6], lgq_[6], lkr_, lg1_; u32x4 lkv_, lgkv_; f32x2_t lcs_;
    const int jj_ = lane & 31;
    int rpos_ = 0;
    if (row >= TC) { int tpos = (row - TC) & 4095; rpos_ = (jj_ >> 4) == 0 ? (tpos >> 6) : (tpos & 63); }
#pragma unroll
    for (int i = 0; i < 6; ++i) { GLOAD4(lq_[i], um + i * 64 + lane); GLOAD4(lgq_[i], p.mla_q_norm_g + l * 384 + i * 64 + lane); }
    GLOAD16(lkv_, um + 384 + lane * 4);
    GLOAD16(lgkv_, p.mla_kv_norm_g + l * 256 + lane * 4);
    GLOAD4(lkr_, um + 640 + jj_);
    GLOAD4(lg1_, g1 + 64 + jj_);
    GLOAD8(lcs_, (const float2*)(p.ws + O_TAB) + 4432 + rpos_ * 8 + (jj_ & 7));
    asm volatile("s_waitcnt vmcnt(0)" : "+v"(lq_[0]), "+v"(lq_[1]), "+v"(lq_[2]), "+v"(lq_[3]), "+v"(lq_[4]), "+v"(lq_[5]),
                 "+v"(lgq_[0]), "+v"(lgq_[1]), "+v"(lgq_[2]), "+v"(lgq_[3]), "+v"(lgq_[4]), "+v"(lgq_[5]),
                 "+v"(lkv_), "+v"(lgkv_), "+v"(lkr_), "+v"(lg1_), "+v"(lcs_) :: "memory");
    {
      float v[6]; float ss = 0.f;
#pragma unroll
      for (int i = 0; i < 6; ++i) { v[i] = lq_[i]; ss += v[i] * v[i]; }
      ss = wave_sum(ss);
      float rstd = rsqrtf(ss * (1.f / 384.f) + EPS);
#pragma unroll
      for (int i = 0; i < 6; ++i) cqn[(size_t)row * 384 + i * 64 + lane] = f2bf(v[i] * rstd * lgq_[i]);
    }
    {
      float4 v = make_float4(__uint_as_float(lkv_[0]), __uint_as_float(lkv_[1]), __uint_as_float(lkv_[2]), __uint_as_float(lkv_[3]));
      float ss = wave_sum(v.x * v.x + v.y * v.y + v.z * v.z + v.w * v.w);
      float rstd = rsqrtf(ss * (1.f / 256.f) + EPS);
      float4 g = make_float4(__uint_as_float(lgkv_[0]), __uint_as_float(lgkv_[1]), __uint_as_float(lgkv_[2]), __uint_as_float(lgkv_[3]));
      float4 o = make_float4(v.x * rstd * g.x, v.y * rstd * g.y, v.z * rstd * g.z, v.w * rstd * g.w);
      if (row < TC) {
        int b = row >> 8, s = row & 255;
        *(float4*)(p.out + OUT_CKV + ((size_t)(b * 2 + l) * 256 + s) * 256 + lane * 4) = o;
      }
      *(uint2*)(ckvn + (size_t)row * 256 + lane * 4) = make_uint2(pack2(o.x, o.y), pack2(o.z, o.w));
    }
    {
      int j = lane & 31;
      float kr = lkr_;
      if (row < TC && lane < 32) {
        int b = row >> 8, s = row & 255;
        p.out[OUT_KR + ((size_t)(b * 2 + l) * 256 + s) * 32 + j] = kr;
      }
      float ss = kr * kr;
#pragma unroll
      for (int o = 16; o > 0; o >>= 1) ss += __shfl_xor(ss, o);
      float val = kr * lg1_;
      float pv = __shfl_xor(val, 8);
      float outv = val;
      if (row >= TC) {
        int half = (j >> 3) & 1;
        float cs = lcs_[0], sn = lcs_[1];
        outv = half == 0 ? val * cs - pv * sn : val * cs + pv * sn;
      }
      if (lane < 32) krr[(size_t)row * 32 + j] = outv;
      if (lane == 0) krss[row] = ss;
    }
  } else {
    int cr = row - T;
    int b = cr >> 9, pp = cr & 511;
    const float* src = p.cache_ckv + ((size_t)(b * 2 + l) * 512 + pp) * 256;
    float4 v = *(const float4*)(src + lane * 4);
    *(uint2*)(ckvn + (size_t)row * 256 + lane * 4) = make_uint2(pack2(v.x, v.y), pack2(v.z, v.w));
    int j = lane & 31;
    float kr = p.cache_krope[((size_t)(b * 2 + l) * 512 + pp) * 32 + j];
    float ss = kr * kr;
#pragma unroll
    for (int o = 16; o > 0; o >>= 1) ss += __shfl_xor(ss, o);
    if (lane < 32) krr[(size_t)row * 32 + j] = kr * g1[64 + j];
    if (lane == 0) krss[row] = ss;
  }
}

DI int hg_entry(int cid, int chunk) { return cid < 256 ? cid * 2 + chunk : 512 + (cid - 256) * 32 + chunk; }

template <bool OUT>
DI void hgrn_chunk(const Params& p, int l, int cid, int chunk, char* smem) {
  const int tid = tid_(), lane = tid & 63, w = tid >> 6;
  int b, hh, dir, L, row0;
  if (cid < 256) { b = cid >> 3; hh = (cid >> 1) & 3; dir = cid & 1; L = 256; row0 = b * 256; }
  else { int c2 = cid - 256; b = c2 >> 3; hh = (c2 >> 1) & 3; dir = c2 & 1; L = 4096; row0 = TC + b * 4096; }
  float* sf = (float*)smem;
  float* sk = sf + 2048;
  float* sq = sk + 2048;
  float* sv = sq + 2048;
  float* so = sv + 2048;
  const u16* ubf = (const u16*)(p.ws + O_UBF);
  float* sloc = (float*)(p.ws + O_SLOC);
  float* dtot = (float*)(p.ws + O_DTOT);
  float S[16];
  if (OUT) {
    if (cid < 256) {
      if (chunk == 0) {
#pragma unroll
        for (int i = 0; i < 16; ++i) S[i] = 0.f;
      } else {
        const float* s = sloc + (size_t)hg_entry(cid, 0) * 4096;
#pragma unroll
        for (int i = 0; i < 16; ++i) S[i] = s[(16 * w + i) * 64 + lane];
      }
    } else {
      const float* s = (const float*)(p.ws + O_SIN) + (size_t)(hg_entry(cid, chunk) - 512) * 4096;
#pragma unroll
      for (int i = 0; i < 16; ++i) S[i] = s[(16 * w + i) * 64 + lane];
    }
  } else {
#pragma unroll
    for (int i = 0; i < 16; ++i) S[i] = 0.f;
  }
  const int kcol = tid & 63;
  float lb = 0.f;
  if (l == 1) {
    float a0 = p.hgrn_lb[(0 * 2 + dir) * 256 + hh * 64 + kcol], a1 = p.hgrn_lb[(1 * 2 + dir) * 256 + hh * 64 + kcol];
    lb = 1.f / (1.f + __expf(a0 - a1));
  }
  float dprod = 1.f;
  unsigned rq[8], rf[8], rv[8];
#define GLOADU16(dst, ptr) asm volatile("global_load_ushort %0, %1, off" : "=v"(dst) : "v"(ptr) : "memory")
#define HG_ISSUE(SC)                                                                  \
  _Pragma("unroll") for (int n = 0; n < 8; ++n) {                                     \
    int i_ = (tid >> 6) + 4 * n;                                                      \
    int tau_ = chunk * 128 + (SC) * 32 + i_;                                          \
    int tpos_ = dir ? (L - 1 - tau_) : tau_;                                          \
    const u16* ur_ = ubf + (size_t)(row0 + tpos_) * 1280 + hh * 64 + kcol;           \
    GLOADU16(rf[n], ur_ + 256 + dir * 256);                                           \
    GLOADU16(rv[n], ur_ + 768);                                                       \
    if (OUT) GLOADU16(rq[n], ur_);                                                    \
  }
  f32x2_t S2[8];
#pragma unroll
  for (int j = 0; j < 8; ++j) S2[j] = (f32x2_t){S[2 * j], S[2 * j + 1]};
  HG_ISSUE(0)
  for (int sc = 0; sc < 4; ++sc) {
    asm volatile("s_waitcnt vmcnt(0)" : "+v"(rf[0]), "+v"(rf[1]), "+v"(rf[2]), "+v"(rf[3]), "+v"(rf[4]), "+v"(rf[5]), "+v"(rf[6]), "+v"(rf[7]),
                 "+v"(rv[0]), "+v"(rv[1]), "+v"(rv[2]), "+v"(rv[3]), "+v"(rv[4]), "+v"(rv[5]), "+v"(rv[6]), "+v"(rv[7]) :: "memory");
    if (OUT) asm volatile("" : "+v"(rq[0]), "+v"(rq[1]), "+v"(rq[2]), "+v"(rq[3]), "+v"(rq[4]), "+v"(rq[5]), "+v"(rq[6]), "+v"(rq[7]) :: "memory");
#pragma unroll
    for (int n = 0; n < 8; ++n) {
      int i = (tid >> 6) + 4 * n;
      float fr = __uint_as_float(rf[n] << 16);
      float e = __expf(-fr);
      float sg = __builtin_amdgcn_rcpf(1.f + e);
      float om = 1.f / (1.f + __expf(fr));
      float f = lb + (1.f - lb) * sg;
      sf[i * 64 + kcol] = f;
      dprod *= f;
      sv[i * 64 + kcol] = __uint_as_float(rv[n] << 16);
      if (OUT) { float q = __uint_as_float(rq[n] << 16); sq[i * 64 + kcol] = q * sigmoidf_(q); }
    }
    if (sc + 1 < 4) { HG_ISSUE(sc + 1) }
    __syncthreads();
    for (int i = 0; i < 32; ++i) {
      const float v = sv[i * 64 + lane];
      const f32x2_t vv = {v, v};
      f32x2_t o2 = {0.f, 0.f};
#pragma unroll
      for (int a = 0; a < 4; ++a) {
        const f32x4 f4 = *(const f32x4*)(sf + i * 64 + 16 * w + 4 * a);
        const f32x2_t fa = {f4[0], f4[1]}, fb = {f4[2], f4[3]};
        S2[2 * a] = __builtin_elementwise_fma(fa, S2[2 * a] - vv, vv);
        S2[2 * a + 1] = __builtin_elementwise_fma(fb, S2[2 * a + 1] - vv, vv);
        if (OUT) {
          const f32x4 q4 = *(const f32x4*)(sq + i * 64 + 16 * w + 4 * a);
          const f32x2_t qa = {q4[0], q4[1]}, qb = {q4[2], q4[3]};
          o2 = __builtin_elementwise_fma(qa, S2[2 * a], o2);
          o2 = __builtin_elementwise_fma(qb, S2[2 * a + 1], o2);
        }
      }
      if (OUT) so[(i * 4 + w) * 64 + lane] = o2[0] + o2[1];
    }
    __syncthreads();
    if (OUT) {
      float* od = (float*)(p.ws + (dir ? O_OB : O_OF));
#pragma unroll
      for (int n = 0; n < 8; ++n) {
        int i = (tid >> 6) + 4 * n;
        int tau = chunk * 128 + sc * 32 + i;
        int tpos = dir ? (L - 1 - tau) : tau;
        float o = so[(i * 4 + 0) * 64 + kcol] + so[(i * 4 + 1) * 64 + kcol] + so[(i * 4 + 2) * 64 + kcol] +
                  so[(i * 4 + 3) * 64 + kcol];
        od[(size_t)(row0 + tpos) * 256 + hh * 64 + kcol] = o;
      }
      __syncthreads();
    }
  }
#pragma unroll
  for (int j = 0; j < 8; ++j) { S[2 * j] = S2[j][0]; S[2 * j + 1] = S2[j][1]; }
  if (!OUT) {
    int e = hg_entry(cid, chunk);
    float* s = sloc + (size_t)e * 4096;
#pragma unroll
    for (int i = 0; i < 16; ++i) s[(16 * w + i) * 64 + lane] = S[i];
    sf[tid] = dprod;
    __syncthreads();
    if (tid < 64) dtot[(size_t)e * 64 + tid] = sf[tid] * sf[64 + tid] * sf[128 + tid] * sf[192 + tid];
    __syncthreads();
  } else if (cid < 256 && chunk == 1) {
    float* s = p.out + OUT_ST + ((size_t)((b * 2 + l) * 2 + dir) * 4 + hh) * 4096;
#pragma unroll
    for (int i = 0; i < 16; ++i) s[(16 * w + i) * 64 + lane] = S[i];
  }
}

template <int R, int NK>
DI void fft_a(const Params& p, int tb, int l2, int k1base, char* smem) {
  const int col = tid_();
  const float2* W = (const float2*)(p.ws + O_TAB) + (R == 16 ? TAB_W16 : TAB_W64);
  const float2* tabL = (const float2*)(p.ws + O_TAB) + (R == 16 ? 80 : 336);
  const float* um = (const float*)(p.ws + O_UM) + (size_t)(tb + l2) * 928 + 672 + col;
  float x[R];
#pragma unroll
  for (int l1 = 0; l1 < R; ++l1) GLOAD4(x[l1], um + (size_t)(R * l1) * 928);
#pragma unroll
  for (int l1 = 0; l1 < R; l1 += 8)
    asm volatile("s_waitcnt vmcnt(0)" : "+v"(x[l1]), "+v"(x[l1 + 1]), "+v"(x[l1 + 2]), "+v"(x[l1 + 3]), "+v"(x[l1 + 4]), "+v"(x[l1 + 5]), "+v"(x[l1 + 6]), "+v"(x[l1 + 7]) :: "memory");
  float2* y = (float2*)(p.ws + O_YFFT);
  float2* sW = (float2*)smem;
  float2* sT = sW + NK * R;
  for (int i = col; i < NK * R; i += 256) sW[i] = W[k1base * R + i];
  if (col < NK) sT[col] = tabL[(k1base + col) * l2];
  __syncthreads();
  for (int k = 0; k < NK; ++k) {
    const int k1 = k1base + k;
    const float2* wr = sW + k * R;
    float yr = 0.f, yi = 0.f;
#pragma unroll
    for (int l1 = 0; l1 < R; ++l1) { float2 w = wr[l1]; yr += x[l1] * w.x; yi -= x[l1] * w.y; if ((l1 & 7) == 7) __builtin_amdgcn_sched_barrier(0); }
    float2 tw = sT[k];
    float re = yr * tw.x + yi * tw.y;
    float im = yi * tw.x - yr * tw.y;
    y[(size_t)(tb + k1 * R + l2) * 256 + col] = make_float2(re, im);
  }
  __syncthreads();
}
DI void fft_a64_sym(const Params& p, int tb, int l2, int k1base, int nkr, char* smem) {
  constexpr int R = 64;
  const int col = tid_();
  const float2* W = (const float2*)(p.ws + O_TAB) + TAB_W64;
  const float2* tabL = (const float2*)(p.ws + O_TAB) + 336;
  const float* um = (const float*)(p.ws + O_UM) + (size_t)(tb + l2) * 928 + 672 + col;
  float x[R];
#pragma unroll
  for (int l1 = 0; l1 < R; ++l1) GLOAD4(x[l1], um + (size_t)(R * l1) * 928);
#pragma unroll
  for (int l1 = 0; l1 < R; l1 += 8)
    asm volatile("s_waitcnt vmcnt(0)" : "+v"(x[l1]), "+v"(x[l1 + 1]), "+v"(x[l1 + 2]), "+v"(x[l1 + 3]), "+v"(x[l1 + 4]), "+v"(x[l1 + 5]), "+v"(x[l1 + 6]), "+v"(x[l1 + 7]) :: "memory");
  float2* y = (float2*)(p.ws + O_YFFT);
  float2* sW = (float2*)smem;
  float2* sT = sW + 17 * R;
  float2* sM = sT + 17;
  for (int i = col; i < nkr * R; i += 256) sW[i] = W[k1base * R + i];
  if (col < nkr) {
    const int k1 = k1base + col;
    sT[col] = tabL[k1 * l2];
    sM[col] = tabL[((64 - k1) & 63) * l2];
  }
  __syncthreads();
  for (int k = 0; k < nkr; ++k) {
    const int k1 = k1base + k;
    const float2* wr = sW + k * R;
    float yr = 0.f, yi = 0.f;
#pragma unroll
    for (int l1 = 0; l1 < R; ++l1) { float2 w = wr[l1]; yr += x[l1] * w.x; yi -= x[l1] * w.y; if ((l1 & 7) == 7) __builtin_amdgcn_sched_barrier(0); }
    const float2 tw = sT[k];
    y[(size_t)(tb + k1 * R + l2) * 256 + col] = make_float2(yr * tw.x + yi * tw.y, yi * tw.x - yr * tw.y);
    if (k1 != 0 && k1 != 32) {
      const float2 tm = sM[k];
      y[(size_t)(tb + (64 - k1) * R + l2) * 256 + col] = make_float2(yr * tm.x - yi * tm.y, -yi * tm.x - yr * tm.y);
    }
  }
  __syncthreads();
}
template <int R, int NK>
DI void fft_c(const Params& p, int tb, int k1, int k2base, char* smem) {
  const int col = tid_();
  const float2* W = (const float2*)(p.ws + O_TAB) + (R == 16 ? TAB_W16 : TAB_W64);
  const float2* y = (const float2*)(p.ws + O_YFFT) + (size_t)(tb + k1 * R) * 256 + col;
  f32x2_t v[R];
#pragma unroll
  for (int l2 = 0; l2 < R; ++l2) GLOAD8(v[l2], y + (size_t)l2 * 256);
#pragma unroll
  for (int l2 = 0; l2 < R; l2 += 8)
    asm volatile("s_waitcnt vmcnt(0)" : "+v"(v[l2]), "+v"(v[l2 + 1]), "+v"(v[l2 + 2]), "+v"(v[l2 + 3]), "+v"(v[l2 + 4]), "+v"(v[l2 + 5]), "+v"(v[l2 + 6]), "+v"(v[l2 + 7]) :: "memory");
  u16* xb = (u16*)(p.ws + O_XBUF);
  const int g = col >> 6, cc = col & 63;
  float2* sW = (float2*)smem;
  for (int i = col; i < NK * R; i += 256) sW[i] = W[k2base * R + i];
  __syncthreads();
  for (int k = 0; k < NK; ++k) {
    const int k2 = k2base + k;
    const float2* wr = sW + k * R;
    float xr = 0.f, xi = 0.f;
#pragma unroll
    for (int l2 = 0; l2 < R; ++l2) {
      float2 w = wr[l2];
      xr += v[l2][0] * w.x + v[l2][1] * w.y;
      xi += v[l2][1] * w.x - v[l2][0] * w.y;
      if ((l2 & 7) == 7) __builtin_amdgcn_sched_barrier(0);
    }
    int row = tb + k1 + R * k2;
    xb[(size_t)row * 512 + g * 128 + cc] = f2bf(xr);
    xb[(size_t)row * 512 + g * 128 + 64 + cc] = f2bf(xi);
  }
  __syncthreads();
}

constexpr int N6_HA = 16 * 31 + 256, N6_FA = 256 + 512, N6_MP = TK / 4;
DI void phase6(const Params& p, int l, char* smem) {
  for (int it = bid_(); it < N6_HA + N6_FA + N6_MP; it += gridDim.x) {
    int t = it;
    if (t < N6_HA) {
      int cid, chunk;
      if (t < 496) { cid = 256 + t / 31; chunk = t % 31; } else { cid = t - 496; chunk = 0; }
      hgrn_chunk<false>(p, l, cid, chunk, smem);
      continue;
    }
    t -= N6_HA;
    if (t < N6_FA) {
      if (t < 256) { int b = t >> 7, r = t & 127; fft_a64_sym(p, TC + b * 4096, r >> 1, (r & 1) ? 17 : 0, (r & 1) ? 16 : 17, smem); }
      else { int u = t - 256; fft_a<16, 16>(p, (u >> 4) * 256, u & 15, 0, smem); }
      continue;
    }
    t -= N6_FA;
    mixprep_rows(p, l, t);
  }
}

DI void hgrn_prefix(const Params& p, int l, int c2, int eb) {
  const int tid = tid_();
  const int e = eb * 256 + tid, k = e >> 6;
  const int b = c2 >> 3, hh = (c2 >> 1) & 3, dir = c2 & 1;
  const float* sloc = (const float*)(p.ws + O_SLOC) + (size_t)(512 + c2 * 32) * 4096 + e;
  const float* dtot = (const float*)(p.ws + O_DTOT) + (size_t)(512 + c2 * 32) * 64 + k;
  float* sin = (float*)(p.ws + O_SIN) + (size_t)(c2 * 32) * 4096 + e;
  float sl[32], dd[32];
  sl[31] = 0.f; dd[31] = 0.f;
#pragma unroll
  for (int j = 0; j < 31; ++j) { GLOAD4(sl[j], sloc + (size_t)j * 4096); GLOAD4(dd[j], dtot + (size_t)j * 64); }
  float S = p.state_hgrn[((size_t)((b * 2 + l) * 2 + dir) * 4 + hh) * 4096 + e];
#pragma unroll
  for (int j = 0; j < 32; j += 8)
    asm volatile("s_waitcnt vmcnt(0)" : "+v"(sl[j]), "+v"(sl[j + 1]), "+v"(sl[j + 2]), "+v"(sl[j + 3]), "+v"(sl[j + 4]), "+v"(sl[j + 5]), "+v"(sl[j + 6]), "+v"(sl[j + 7]),
                 "+v"(dd[j]), "+v"(dd[j + 1]), "+v"(dd[j + 2]), "+v"(dd[j + 3]), "+v"(dd[j + 4]), "+v"(dd[j + 5]), "+v"(dd[j + 6]), "+v"(dd[j + 7]) :: "memory");
  sin[0] = S;
#pragma unroll
  for (int j = 0; j < 31; ++j) { S = dd[j] * S + sl[j]; sin[(size_t)(j + 1) * 4096] = S; }
}

constexpr int N7_Q = 128 * 6, N7_KV = (TK / 128) * 8, N7_FC = 256 + 512, N7_HB = 256;
DI void phase7(const Params& p, int l, char* smem) {
  u16* qraw = (u16*)(p.ws + O_H);
  const u16* cqn = (const u16*)(p.ws + O_CQN);
  const u16* ckvn = (const u16*)(p.ws + O_CKVN);
  const u16* wq = (const u16*)(p.ws + O_WQ) + (size_t)l * 768 * 384;
  const u16* wkv = (const u16*)(p.ws + O_WKV) + (size_t)l * 1024 * 256;
  const float* krr = (const float*)(p.ws + O_KRR);
  const float* krss = (const float*)(p.ws + O_KRSS);
  const float* g1 = p.mla_qk_norm_g + (size_t)(l * 2 + 1) * 96;
  u16* kbuf = (u16*)(p.ws + O_KBUF);
  u16* vt = (u16*)(p.ws + O_VT);
  auto epi_q = [&](f32x4 (&acc)[4][4], int mb, int nb, int lane) {
    const int l15 = lane & 15, quad = lane >> 4;
#pragma unroll
    for (int ni = 0; ni < 4; ++ni)
#pragma unroll
      for (int mi = 0; mi < 4; ++mi)
#pragma unroll
        for (int j = 0; j < 4; ++j) {
          int row = mb + mi * 16 + quad * 4 + j;
          qraw[(size_t)row * 768 + nb + ni * 16 + l15] = f2bf(acc[mi][ni][j]);
        }
  };
  auto epi_kv = [&](f32x4 (&acc)[4][4], int mb, int nb, int lane) {
    const int l15 = lane & 15, quad = lane >> 4;
    const int hd = nb >> 7, isv = (nb >> 6) & 1;
#pragma unroll
    for (int mi = 0; mi < 4; ++mi) {
      int r0 = mb + mi * 16 + quad * 4;
      size_t kb_base, vt_base; int key0, Lk;
      if (r0 < TC) { int b = r0 >> 8; key0 = r0 & 255; Lk = 256; kb_base = (size_t)(b * 8 + hd) * 256 * 96; vt_base = (size_t)(b * 8 + hd) * 64 * 256; }
      else {
        int b;
        if (r0 < T) { b = (r0 - TC) >> 12; key0 = 512 + ((r0 - TC) & 4095); }
        else { b = (r0 - T) >> 9; key0 = (r0 - T) & 511; }
        Lk = 4608;
        kb_base = (size_t)TC * 8 * 96 + (size_t)(b * 8 + hd) * 4608 * 96;
        vt_base = (size_t)TC * 8 * 64 + (size_t)(b * 8 + hd) * 64 * 4608;
      }
      if (!isv) {
        float kss[4]; f32x2_t kr2v[4];
#pragma unroll
        for (int j = 0; j < 4; ++j) { GLOAD4(kss[j], krss + (r0 + j)); GLOAD8(kr2v[j], krr + (size_t)(r0 + j) * 32 + l15 * 2); }
        asm volatile("s_waitcnt vmcnt(0)" : "+v"(kss[0]), "+v"(kss[1]), "+v"(kss[2]), "+v"(kss[3]), "+v"(kr2v[0]), "+v"(kr2v[1]), "+v"(kr2v[2]), "+v"(kr2v[3]) :: "memory");
#pragma unroll
        for (int j = 0; j < 4; ++j) {
          float ss = 0.f;
#pragma unroll
          for (int ni = 0; ni < 4; ++ni) ss += acc[mi][ni][j] * acc[mi][ni][j];
          ss += __shfl_xor(ss, 1); ss += __shfl_xor(ss, 2); ss += __shfl_xor(ss, 4); ss += __shfl_xor(ss, 8);
          int row = r0 + j;
          float rstd = rsqrtf((ss + kss[j]) * (1.f / 96.f) + EPS);
          u16* kd = kbuf + kb_base + (size_t)(key0 + j) * 96;
#pragma unroll
          for (int ni = 0; ni < 4; ++ni) kd[ni * 16 + l15] = f2bf(acc[mi][ni][j] * rstd * g1[ni * 16 + l15]);
          *(unsigned*)(kd + 64 + l15 * 2) = pack2(kr2v[j][0] * rstd, kr2v[j][1] * rstd);
        }
      } else {
#pragma unroll
        for (int ni = 0; ni < 4; ++ni) {
          int d = ni * 16 + l15;
          *(uint2*)(vt + vt_base + (size_t)d * Lk + key0) =
              make_uint2(pack2(acc[mi][ni][0], acc[mi][ni][1]), pack2(acc[mi][ni][2], acc[mi][ni][3]));
        }
      }
    }
  };
  for (int it = bid_(); it < N7_KV + N7_Q + N7_FC + N7_HB; it += gridDim.x) {
    int t = it;
    if (t < N7_KV) { gemm_tile(ckvn, 256, wkv, 256, 256, (t >> 3) * 128, (t & 7) * 128, smem, epi_kv); continue; }
    t -= N7_KV;
    if (t < N7_Q) { gemm_tile(cqn, 384, wq, 384, 384, (t / 6) * 128, (t % 6) * 128, smem, epi_q); continue; }
    t -= N7_Q;
    if (t < N7_FC) {
      if (t < 256) { int b = t >> 7, r = t & 127; fft_c<64, 32>(p, TC + b * 4096, r >> 1, (r & 1) * 32, smem); }
      else { int u = t - 256; fft_c<16, 16>(p, (u >> 4) * 256, u & 15, 0, smem); }
      continue;
    }
    t -= N7_FC;
    hgrn_prefix(p, l, t >> 4, t & 15);
  }
}

DI int kappa(int r) { return (r & ~12) | ((r & 8) >> 1) | ((r & 4) << 1); }

DI void attn_item(const Params& p, int l, bool lat, int b, int hd, int qt, char* smem) {
  const int tid = tid_(), lane = tid & 63, w = tid >> 6;
  const int r = lane & 31, hh = lane >> 5;
  const int Lk = lat ? 4608 : 256;
  const u16* kb = (const u16*)(p.ws + O_KBUF) + (lat ? (size_t)TC * 8 * 96 + (size_t)(b * 8 + hd) * 4608 * 96 : (size_t)(b * 8 + hd) * 256 * 96);
  const u16* vtb = (const u16*)(p.ws + O_VT) + (lat ? (size_t)TC * 8 * 64 + (size_t)(b * 8 + hd) * 64 * 4608 : (size_t)(b * 8 + hd) * 64 * 256);
  const int qrow = (lat ? TC + b * 4096 : b * 256) + qt * 128 + w * 32 + r;
  bf16x8 qf[6];
  {
    const u16* qp = (const u16*)(p.ws + O_H) + (size_t)qrow * 768 + hd * 96;
    const float* g0 = p.mla_qk_norm_g + (size_t)(l * 2) * 96;
    uint4 raw[6];
    float ss = 0.f;
#pragma unroll
    for (int s = 0; s < 6; ++s) {
      raw[s] = *(const uint4*)(qp + 16 * s + 8 * hh);
      unsigned uu[4] = {raw[s].x, raw[s].y, raw[s].z, raw[s].w};
#pragma unroll
      for (int j = 0; j < 4; ++j) {
        float a = __uint_as_float(uu[j] << 16), c = __uint_as_float(uu[j] & 0xffff0000u);
        ss += a * a + c * c;
      }
    }
    ss += __shfl_xor(ss, 32);
    const float rstd = rsqrtf(ss * (1.f / 96.f) + EPS);
    const float qs = 0.10206207261596577f * 1.4426950408889634f;
    const int tpos = (qrow - TC) & 4095;
    const float2* rtab = (const float2*)(p.ws + O_TAB) + 4432;
#pragma unroll
    for (int s = 0; s < 6; ++s) {
      unsigned uu[4] = {raw[s].x, raw[s].y, raw[s].z, raw[s].w};
      float qv[8];
#pragma unroll
      for (int j = 0; j < 4; ++j) {
        qv[2 * j] = __uint_as_float(uu[j] << 16) * rstd * g0[16 * s + 8 * hh + 2 * j];
        qv[2 * j + 1] = __uint_as_float(uu[j] & 0xffff0000u) * rstd * g0[16 * s + 8 * hh + 2 * j + 1];
      }
      if (s >= 4 && lat) {
        int pos = s == 4 ? (tpos >> 6) : (tpos & 63);
#pragma unroll
        for (int j = 0; j < 8; ++j) {
          float val = qv[j];
          float pv = __shfl_xor(val, 32);
          float2 cs2 = rtab[pos * 8 + j];
          qv[j] = hh == 0 ? val * cs2.x - pv * cs2.y : val * cs2.x + pv * cs2.y;
        }
      }
      unsigned pk[4];
#pragma unroll
      for (int j = 0; j < 4; ++j) pk[j] = pack2(qv[2 * j] * qs, qv[2 * j + 1] * qs);
      uint4 u4 = make_uint4(pk[0], pk[1], pk[2], pk[3]);
      qf[s] = *(bf16x8*)&u4;
    }
  }
  f32x16 o0, o1;
#pragma unroll
  for (int i = 0; i < 16; ++i) { o0[i] = 0.f; o1[i] = 0.f; }
  float lsum = 0.f;
  float mfix;
  {
    const float* gq = p.mla_qk_norm_g + (size_t)(l * 2) * 96;
    float mq = 0.f, mk = 0.f;
    for (int e = 0; e < 96; ++e) { mq = fmaxf(mq, fabsf(gq[e])); mk = fmaxf(mk, fabsf(gq[96 + e])); }
    mfix = fminf(9.797958971132712f * 1.4426950408889634f * mq * mk, 100.f);
  }
  constexpr int KST = 64 * 208, VST = 64 * 144, STG = KST + VST;
  u32x4 a0, a1, a2, a3, a4, b0, b1, b2, b3, b4;
  const u16* kg = kb + tid * 8;
  const u16* vg = vtb + (size_t)(tid >> 3) * Lk + (tid & 7) * 8;
  const int ksoff0 = (tid / 12) * 208 + (tid % 12) * 16;
  const int ksoff1 = ((tid + 256) / 12) * 208 + ((tid + 256) % 12) * 16;
  const int ksoff2 = ((tid + 512) / 12) * 208 + ((tid + 512) % 12) * 16;
  const int vsoff = KST + (tid >> 3) * 144 + (tid & 7) * 16;
  const int nkt = Lk >> 6;
  const unsigned lds0a = (unsigned)(size_t)smem;
#define ATT_GLOAD_S(S, KT)                                               \
  {                                                                      \
    const int kt_ = (KT) < nkt ? (KT) : nkt - 1;                         \
    GLOAD16(S##0, kg + (size_t)kt_ * 6144);                              \
    GLOAD16(S##1, kg + (size_t)kt_ * 6144 + 2048);                       \
    GLOAD16(S##2, kg + (size_t)kt_ * 6144 + 4096);                       \
    GLOAD16(S##3, vg + kt_ * 64);                                        \
    GLOAD16(S##4, vg + (size_t)32 * Lk + kt_ * 64);                      \
  }
#define ATT_SSTORE_S(S, BUF)                                             \
  {                                                                      \
    char* base_ = smem + (BUF) * STG;                                    \
    asm volatile("s_waitcnt vmcnt(5)" : "+v"(S##0), "+v"(S##1), "+v"(S##2), "+v"(S##3), "+v"(S##4) :: "memory"); \
    *(u32x4*)(base_ + ksoff0) = S##0;                                    \
    *(u32x4*)(base_ + ksoff1) = S##1;                                    \
    *(u32x4*)(base_ + ksoff2) = S##2;                                    \
    *(u32x4*)(base_ + vsoff) = S##3;                                     \
    *(u32x4*)(base_ + vsoff + 32 * 144) = S##4;                          \
  }
  const int kr_ = kappa(r);
  auto att_compute = [&](const int bsel) {
    const unsigned kaddr = lds0a + bsel * STG + kr_ * 208 + hh * 16;
    const unsigned vaddr = lds0a + bsel * STG + KST + r * 144 + hh * 16;
    bf16x8 ka[6], kc[6];
    DSR(ka[0], kaddr, 0);    DSR(kc[0], kaddr, 6656);
    DSR(ka[1], kaddr, 32);   DSR(kc[1], kaddr, 6688);
    DSR(ka[2], kaddr, 64);   DSR(kc[2], kaddr, 6720);
    DSR(ka[3], kaddr, 96);   DSR(kc[3], kaddr, 6752);
    DSR(ka[4], kaddr, 128);  DSR(kc[4], kaddr, 6784);
    DSR(ka[5], kaddr, 160);  DSR(kc[5], kaddr, 6816);
    f32x16 s0, s1;
#pragma unroll
    for (int i = 0; i < 16; ++i) { s0[i] = -mfix; s1[i] = -mfix; }
#define ATT_W2(N, X, Y) asm volatile("s_waitcnt lgkmcnt(" #N ")" : "+v"(X), "+v"(Y) :: "memory")
    ATT_W2(10, ka[0], kc[0]);
    s0 = __builtin_amdgcn_mfma_f32_32x32x16_bf16(ka[0], qf[0], s0, 0, 0, 0);
    s1 = __builtin_amdgcn_mfma_f32_32x32x16_bf16(kc[0], qf[0], s1, 0, 0, 0);
    ATT_W2(8, ka[1], kc[1]);
    s0 = __builtin_amdgcn_mfma_f32_32x32x16_bf16(ka[1], qf[1], s0, 0, 0, 0);
    s1 = __builtin_amdgcn_mfma_f32_32x32x16_bf16(kc[1], qf[1], s1, 0, 0, 0);
    ATT_W2(6, ka[2], kc[2]);
    s0 = __builtin_amdgcn_mfma_f32_32x32x16_bf16(ka[2], qf[2], s0, 0, 0, 0);
    s1 = __builtin_amdgcn_mfma_f32_32x32x16_bf16(kc[2], qf[2], s1, 0, 0, 0);
    ATT_W2(4, ka[3], kc[3]);
    s0 = __builtin_amdgcn_mfma_f32_32x32x16_bf16(ka[3], qf[3], s0, 0, 0, 0);
    s1 = __builtin_amdgcn_mfma_f32_32x32x16_bf16(kc[3], qf[3], s1, 0, 0, 0);
    ATT_W2(2, ka[4], kc[4]);
    s0 = __builtin_amdgcn_mfma_f32_32x32x16_bf16(ka[4], qf[4], s0, 0, 0, 0);
    s1 = __builtin_amdgcn_mfma_f32_32x32x16_bf16(kc[4], qf[4], s1, 0, 0, 0);
    ATT_W2(0, ka[5], kc[5]);
    s0 = __builtin_amdgcn_mfma_f32_32x32x16_bf16(ka[5], qf[5], s0, 0, 0, 0);
    s1 = __builtin_amdgcn_mfma_f32_32x32x16_bf16(kc[5], qf[5], s1, 0, 0, 0);
    __builtin_amdgcn_sched_barrier(0);
    bf16x8 va[4], vc[4];
    DSR(va[0], vaddr, 0);   DSR(vc[0], vaddr, 4608);
    DSR(va[1], vaddr, 32);  DSR(vc[1], vaddr, 4640);
    DSR(va[2], vaddr, 64);  DSR(vc[2], vaddr, 4672);
    DSR(va[3], vaddr, 96);  DSR(vc[3], vaddr, 4704);
#pragma unroll
    for (int i = 0; i < 16; ++i) { s0[i] = __builtin_amdgcn_exp2f(s0[i]); lsum += s0[i]; s1[i] = __builtin_amdgcn_exp2f(s1[i]); lsum += s1[i]; }
    bf16x8 pb[4];
#pragma unroll
    for (int kbk = 0; kbk < 2; ++kbk)
#pragma unroll
      for (int t2 = 0; t2 < 2; ++t2) {
        unsigned pk[4];
#pragma unroll
        for (int j = 0; j < 4; ++j) {
          float x0 = kbk ? s1[8 * t2 + 2 * j] : s0[8 * t2 + 2 * j];
          float x1 = kbk ? s1[8 * t2 + 2 * j + 1] : s0[8 * t2 + 2 * j + 1];
          pk[j] = pack2(x0, x1);
        }
        uint4 u4 = make_uint4(pk[0], pk[1], pk[2], pk[3]);
        pb[kbk * 2 + t2] = *(bf16x8*)&u4;
      }
    ATT_W2(6, va[0], vc[0]);
    o0 = __builtin_amdgcn_mfma_f32_32x32x16_bf16(va[0], pb[0], o0, 0, 0, 0);
    o1 = __builtin_amdgcn_mfma_f32_32x32x16_bf16(vc[0], pb[0], o1, 0, 0, 0);
    ATT_W2(4, va[1], vc[1]);
    o0 = __builtin_amdgcn_mfma_f32_32x32x16_bf16(va[1], pb[1], o0, 0, 0, 0);
    o1 = __builtin_amdgcn_mfma_f32_32x32x16_bf16(vc[1], pb[1], o1, 0, 0, 0);
    ATT_W2(2, va[2], vc[2]);
    o0 = __builtin_amdgcn_mfma_f32_32x32x16_bf16(va[2], pb[2], o0, 0, 0, 0);
    o1 = __builtin_amdgcn_mfma_f32_32x32x16_bf16(vc[2], pb[2], o1, 0, 0, 0);
    ATT_W2(0, va[3], vc[3]);
    o0 = __builtin_amdgcn_mfma_f32_32x32x16_bf16(va[3], pb[3], o0, 0, 0, 0);
    o1 = __builtin_amdgcn_mfma_f32_32x32x16_bf16(vc[3], pb[3], o1, 0, 0, 0);
    __builtin_amdgcn_sched_barrier(0);
  };
  ATT_GLOAD_S(a, 0)
  ATT_GLOAD_S(b, 1)
  ATT_SSTORE_S(a, 0)
  __syncthreads();
  for (int kt = 0; kt < nkt; kt += 2) {
    ATT_GLOAD_S(a, kt + 2)
    att_compute(0);
    ATT_SSTORE_S(b, 1)
    __syncthreads();
    ATT_GLOAD_S(b, kt + 3)
    att_compute(1);
    ATT_SSTORE_S(a, 0)
    __syncthreads();
  }
  asm volatile("s_waitcnt vmcnt(0)" : "+v"(a0), "+v"(a1), "+v"(a2), "+v"(a3), "+v"(a4), "+v"(b0), "+v"(b1), "+v"(b2), "+v"(b3), "+v"(b4) :: "memory");
  lsum += __shfl_xor(lsum, 32);
  float inv = 1.f / lsum;
  u16* om = (u16*)(p.ws + O_OMLA) + (size_t)qrow * 512 + hd * 64;
#pragma unroll
  for (int gq = 0; gq < 4; ++gq) {
    int d = 8 * gq + 4 * hh;
    *(uint2*)(om + d) = make_uint2(pack2(o0[4 * gq] * inv, o0[4 * gq + 1] * inv), pack2(o0[4 * gq + 2] * inv, o0[4 * gq + 3] * inv));
    *(uint2*)(om + 32 + d) = make_uint2(pack2(o1[4 * gq] * inv, o1[4 * gq + 1] * inv), pack2(o1[4 * gq + 2] * inv, o1[4 * gq + 3] * inv));
  }
}

constexpr int N8_AL = 512, N8_AC = 512, N8_HC = 1024, N8_F2 = 256;
DI void phase8(const Params& p, int l, char* smem) {
  const u16* xb = (const u16*)(p.ws + O_XBUF);
  const u16* wf = (const u16*)(p.ws + O_WF) + (size_t)l * 256 * 512;
  u16* ofn = (u16*)(p.ws + O_OFN);
  auto epi_f = [&](f32x4 (&acc)[4][4], int mb, int nb, int lane) {
    const int l15 = lane & 15, quad = lane >> 4;
    const float sc = mb < TC ? (1.f / 128.f) : (1.f / 512.f);
#pragma unroll
    for (int ni = 0; ni < 4; ++ni)
#pragma unroll
      for (int mi = 0; mi < 4; ++mi)
#pragma unroll
        for (int j = 0; j < 4; ++j) {
          int row = mb + mi * 16 + quad * 4 + j;
          ofn[(size_t)row * 256 + nb + ni * 16 + l15] = f2bf(acc[mi][ni][j] * sc);
        }
  };
  for (int it = bid_(); it < N8_AL + N8_AC + N8_HC + N8_F2; it += gridDim.x) {
    int t = it;
    if (t < N8_AL + N8_AC) {
      bool lat = t < N8_AL;
      int b, hd, qt;
      if (lat) {
        int x = t & 7, y = t >> 3;
        int bh = x * 2 + (y >> 5);
        qt = y & 31; b = bh >> 3; hd = bh & 7;
      } else {
        int u = t - N8_AL;
        b = u >> 4; hd = (u >> 1) & 7; qt = u & 1;
      }
      attn_item(p, l, lat, b, hd, qt, smem);
      continue;
    }
    t -= N8_AL + N8_AC;
    if (t < N8_HC) {
      int cid, chunk;
      if (t < 512) { cid = 256 + (t >> 5); chunk = t & 31; }
      else { int u = t - 512; cid = u >> 1; chunk = u & 1; }
      hgrn_chunk<true>(p, l, cid, chunk, smem);
      continue;
    }
    t -= N8_HC;
    gemm_tile(xb + (t & 1) * 256, 512, wf + (t & 1) * 256, 512, 256, (t >> 1) * 128, (t & 1) * 128, smem, epi_f);
  }
}

DI void phase9(const Params& p, int l) {
  const int tid = tid_(), lane = tid & 63, wid = tid >> 6;
  u16* cat = (u16*)(p.ws + O_H);
  const float* of = (const float*)(p.ws + O_OF);
  const float* ob = (const float*)(p.ws + O_OB);
  const u16* ubf = (const u16*)(p.ws + O_UBF);
  const u16* omla = (const u16*)(p.ws + O_OMLA);
  const u16* ofn = (const u16*)(p.ws + O_OFN);
  for (int rb = bid_(); rb < T / 4; rb += gridDim.x) {
    int row = rb * 4 + wid;
    u32x4 la_, lb_, lm_, lgh_, lgm0_, lgm1_, lgf_; f32x2_t lg_, lf_;
    GLOAD16(la_, of + (size_t)row * 256 + lane * 4);
    GLOAD16(lb_, ob + (size_t)row * 256 + lane * 4);
    GLOAD8(lg_, ubf + (size_t)row * 1280 + 1024 + lane * 4);
    GLOAD16(lm_, omla + (size_t)row * 512 + lane * 8);
    GLOAD8(lf_, ofn + (size_t)row * 256 + lane * 4);
    GLOAD16(lgh_, p.hgrn_norm_g + l * 64 + (lane & 15) * 4);
    GLOAD16(lgm0_, p.mla_out_norm_g + l * 512 + lane * 8);
    GLOAD16(lgm1_, p.mla_out_norm_g + l * 512 + lane * 8 + 4);
    GLOAD16(lgf_, p.fnet_norm_g + l * 256 + lane * 4);
    asm volatile("s_waitcnt vmcnt(0)" : "+v"(la_), "+v"(lb_), "+v"(lg_), "+v"(lm_), "+v"(lf_), "+v"(lgh_), "+v"(lgm0_), "+v"(lgm1_), "+v"(lgf_) :: "memory");
    {
      float4 a = make_float4(__uint_as_float(la_[0]), __uint_as_float(la_[1]), __uint_as_float(la_[2]), __uint_as_float(la_[3]));
      float4 b = make_float4(__uint_as_float(lb_[0]), __uint_as_float(lb_[1]), __uint_as_float(lb_[2]), __uint_as_float(lb_[3]));
      float4 o = make_float4(a.x + b.x, a.y + b.y, a.z + b.z, a.w + b.w);
      float ss = o.x * o.x + o.y * o.y + o.z * o.z + o.w * o.w;
      ss += __shfl_xor(ss, 1); ss += __shfl_xor(ss, 2); ss += __shfl_xor(ss, 4); ss += __shfl_xor(ss, 8);
      float rstd = rsqrtf(ss * (1.f / 64.f) + EPS);
      float4 g = make_float4(__uint_as_float(lgh_[0]), __uint_as_float(lgh_[1]), __uint_as_float(lgh_[2]), __uint_as_float(lgh_[3]));
      uint2 gr = make_uint2(__float_as_uint(lg_[0]), __float_as_uint(lg_[1]));
      float g0 = __uint_as_float(gr.x << 16), g1 = __uint_as_float(gr.x & 0xffff0000u);
      float g2 = __uint_as_float(gr.y << 16), g3 = __uint_as_float(gr.y & 0xffff0000u);
      float r0 = o.x * rstd * g.x * (g0 * sigmoidf_(g0));
      float r1 = o.y * rstd * g.y * (g1 * sigmoidf_(g1));
      float r2 = o.z * rstd * g.z * (g2 * sigmoidf_(g2));
      float r3 = o.w * rstd * g.w * (g3 * sigmoidf_(g3));
      *(uint2*)(cat + (size_t)row * DM + lane * 4) = make_uint2(pack2(r0, r1), pack2(r2, r3));
    }
    {
      uint4 raw = make_uint4(lm_[0], lm_[1], lm_[2], lm_[3]);
      unsigned uu[4] = {raw.x, raw.y, raw.z, raw.w};
      float v[8]; float ss = 0.f;
#pragma unroll
      for (int j = 0; j < 4; ++j) { v[2 * j] = __uint_as_float(uu[j] << 16); v[2 * j + 1] = __uint_as_float(uu[j] & 0xffff0000u); }
#pragma unroll
      for (int j = 0; j < 8; ++j) ss += v[j] * v[j];
      ss = wave_sum(ss);
      float rstd = rsqrtf(ss * (1.f / 512.f) + EPS);
      const float g[8] = {__uint_as_float(lgm0_[0]), __uint_as_float(lgm0_[1]), __uint_as_float(lgm0_[2]), __uint_as_float(lgm0_[3]), __uint_as_float(lgm1_[0]), __uint_as_float(lgm1_[1]), __uint_as_float(lgm1_[2]), __uint_as_float(lgm1_[3])};
      unsigned pk[4];
#pragma unroll
      for (int j = 0; j < 4; ++j) pk[j] = pack2(v[2 * j] * rstd * g[2 * j], v[2 * j + 1] * rstd * g[2 * j + 1]);
      *(uint4*)(cat + (size_t)row * DM + 256 + lane * 8) = make_uint4(pk[0], pk[1], pk[2], pk[3]);
    }
    {
      uint2 raw = make_uint2(__float_as_uint(lf_[0]), __float_as_uint(lf_[1]));
      float v0 = __uint_as_float(raw.x << 16), v1 = __uint_as_float(raw.x & 0xffff0000u);
      float v2 = __uint_as_float(raw.y << 16), v3 = __uint_as_float(raw.y & 0xffff0000u);
      float ss = wave_sum(v0 * v0 + v1 * v1 + v2 * v2 + v3 * v3);
      float rstd = rsqrtf(ss * (1.f / 256.f) + EPS);
      float4 g = make_float4(__uint_as_float(lgf_[0]), __uint_as_float(lgf_[1]), __uint_as_float(lgf_[2]), __uint_as_float(lgf_[3]));
      *(uint2*)(cat + (size_t)row * DM + 768 + lane * 4) =
          make_uint2(pack2(v0 * rstd * g.x, v1 * rstd * g.y), pack2(v2 * rstd * g.z, v3 * rstd * g.w));
    }
  }
}


#define XB_TMO      128
#define XB_XCNT(j)  (256  + 64 * (j))
#define XB_XSUB(j)  (1280 + 64 * (j))
#define XB_XGEN(j)  (2304 + 64 * (j))
#define XB_TOP      3328
#define XB_TOPGEN   3392
#define XCD_BAR_WORDS 3456
#define XB_SPIN_CAP (1u << 22)
DI unsigned xb_ld(unsigned* p) { return __hip_atomic_load(p, __ATOMIC_RELAXED, __HIP_MEMORY_SCOPE_AGENT); }
DI unsigned xb_add(unsigned* p, unsigned v) { return __hip_atomic_fetch_add(p, v, __ATOMIC_RELAXED, __HIP_MEMORY_SCOPE_AGENT); }
DI unsigned xb_xcc_id() { return (unsigned)__builtin_amdgcn_s_getreg((3 << 11) | 20) & 0xFu; }
#define XB_SPIN(cond, bar) do { unsigned _sp = 0; while (cond) { __builtin_amdgcn_s_sleep(1); \
    if ((++_sp & 255u) == 0u) { if (xb_ld(&(bar)[XB_TMO])) break; if (_sp > XB_SPIN_CAP) { atomicAdd(&(bar)[XB_TMO], 1u); break; } } } } while (0)
struct XcdBarrier { unsigned* bar; unsigned x, nloc, nx; };
DI void xcd_barrier_complete(unsigned* bar, unsigned x, unsigned& nloc, unsigned& nx) {
  const unsigned G = gridDim.x;
  unsigned sum, cnt, mine, sp = 0u;
  for (;;) {
    sum = 0u; cnt = 0u; mine = 0u;
#pragma unroll
    for (unsigned j = 0; j < 16; ++j) { const unsigned c = xb_ld(&bar[XB_XCNT(j)]); sum += c; cnt += (c > 0u) ? 1u : 0u; mine = (j == x) ? c : mine; }
    if (sum == G) break;
    __builtin_amdgcn_s_sleep(1);
    if ((++sp & 255u) == 0u) { if (xb_ld(&bar[XB_TMO])) break; if (sp > XB_SPIN_CAP) { atomicAdd(&bar[XB_TMO], 1u); break; } }
  }
  nloc = mine > 0u ? mine : 1u; nx = cnt > 0u ? cnt : 1u;
}
DI void xcd_barrier(XcdBarrier& b) {
  asm volatile("s_waitcnt vmcnt(0)" ::: "memory");
  __syncthreads();
  if (threadIdx.x == 0) {
    unsigned* bar = b.bar;
    __builtin_amdgcn_s_waitcnt(0);
    if (b.nloc == 0u) xcd_barrier_complete(bar, b.x, b.nloc, b.nx);
    const unsigned nloc = b.nloc, nx = b.nx;
    const unsigned old = xb_add(&bar[XB_XSUB(b.x)], 1u);
    const unsigned gen = old / nloc;
    if (old + 1u == (gen + 1u) * nloc) {
      __builtin_amdgcn_fence(__ATOMIC_RELEASE, "agent");
      asm volatile("s_waitcnt vmcnt(0)" ::: "memory");
      const unsigned og = xb_add(&bar[XB_TOP], 1u);
      const unsigned tg = og / nx;
      if (og + 1u == (tg + 1u) * nx) xb_add(&bar[XB_TOPGEN], 1u);
      else XB_SPIN(xb_ld(&bar[XB_TOPGEN]) == tg, bar);
      __builtin_amdgcn_fence(__ATOMIC_ACQUIRE, "agent");
      xb_add(&bar[XB_XGEN(b.x)], 1u);
      asm volatile("s_waitcnt vmcnt(0)" ::: "memory");
    } else {
      XB_SPIN(xb_ld(&bar[XB_XGEN(b.x)]) == gen, bar);
      __builtin_amdgcn_fence(__ATOMIC_ACQUIRE, "agent");
      asm volatile("s_waitcnt vmcnt(0)" ::: "memory");
    }
  }
  __syncthreads();
}

constexpr int NPHASE = 1 + 2 * 13;
DI void run_phase(const Params& p, int ph, char* smem, int shint = -1) {
  if (ph == 0) { phase_prep(p, smem); return; }
  int l = (ph - 1) / 13, s = shint >= 0 ? shint : (ph - 1) % 13;
  switch (s) {
    case 0: phase_norm(p, l, 0, l == 0); break;
    case 1: phase_ffn_gu(p, l, 0, smem); break;
    case 2: phase_gemm_resid(p, (const u16*)(p.ws + O_BIG), DFF, (const u16*)(p.ws + O_WDN) + (size_t)(l * 2 + 0) * DM * DFF, l, 2, 0.5f, smem); break;
    case 3: phase_norm(p, l, 1, false); break;
    case 4: phase_win(p, l, smem); break;
    case 5: phase6(p, l, smem); break;
    case 6: phase7(p, l, smem); break;
    case 7: phase8(p, l, smem); break;
    case 8: phase9(p, l); break;
    case 9: phase_gemm_resid(p, (const u16*)(p.ws + O_H), DM, (const u16*)(p.ws + O_WO) + (size_t)l * DM * DM, l, 5, 1.0f, smem); break;
    case 10: phase_norm(p, l, 2, false); break;
    case 11: phase_ffn_gu(p, l, 1, smem); break;
    case 12: phase_gemm_resid(p, (const u16*)(p.ws + O_BIG), DFF, (const u16*)(p.ws + O_WDN) + (size_t)(l * 2 + 1) * DM * DFF, l, 8, 0.5f, smem); break;
  }
}

#if MEGA
__global__ void __launch_bounds__(256, 2) mega_kernel(Params p, int ph0, int ph1) {
  __shared__ __attribute__((aligned(16))) char smem[SMEM_BYTES];
  cg::grid_group grid = cg::this_grid();
  XcdBarrier xb;
  xb.bar = (unsigned*)(p.ws + O_BAR); xb.x = xb_xcc_id(); xb.nloc = 0u; xb.nx = 0u;
  if (ph1 - ph0 > 1 && threadIdx.x == 0) (void)xb_add(&xb.bar[XB_XCNT(xb.x)], 1u);
  for (int ph = ph0; ph < ph1; ++ph) {
    run_phase(p, ph, smem);
#ifdef PROBE_DUP
    if (ph > 0 && ((PROBE_DUP >> ((ph - 1) % 13)) & 1)) { xcd_barrier(xb); run_phase(p, ph, smem); }
#endif
    if (ph + 1 < ph1) { if (p.ws == nullptr) grid.sync(); else xcd_barrier(xb); }
  }
}
#else
template <int S>
__global__ void __launch_bounds__(256, 2) phase_kernel(Params p, int l) {
  __shared__ __attribute__((aligned(16))) char smem[SMEM_BYTES];
  if (S < 0) phase_prep(p, smem); else run_phase(p, 1 + l * 13 + S, smem, S);
}
#endif

extern "C" void kernel_launch(void* const* d_in, const int* in_sizes, int n_in, void* d_out, int out_size, void* d_ws,
                              size_t ws_size, hipStream_t stream) {
  Params p{};
  const float** pp = (const float**)&p;
  for (int i = 0; i < 24; ++i) pp[i] = (const float*)d_in[i];
  p.out = (float*)d_out;
  p.ws = (char*)d_ws;
  if (ws_size < WS_TOTAL) { fprintf(stderr, "workspace too small: %zu < %zu\n", ws_size, (size_t)WS_TOTAL); return; }
#if MEGA
  static int grid_blocks = 0;
  if (!grid_blocks) {
    int dev = 0, cus = 0, per_cu = 0;
    hipGetDevice(&dev);
    hipDeviceGetAttribute(&cus, hipDeviceAttributeMultiprocessorCount, dev);
    hipOccupancyMaxActiveBlocksPerMultiprocessor(&per_cu, mega_kernel, 256, 0);
    (void)per_cu;
    grid_blocks = cus * 2;
  }
  hipMemsetAsync(p.ws + O_BAR, 0, XCD_BAR_WORDS * 4, stream);
#if MEGA == 2
  for (int ph = 0; ph < NPHASE; ++ph) mega_kernel<<<grid_blocks, 256, 0, stream>>>(p, ph, ph + 1);
#else
  int ph0 = 0, ph1 = NPHASE;
  void* args[] = {&p, &ph0, &ph1};
  hipError_t e = hipLaunchCooperativeKernel((void*)mega_kernel, dim3(grid_blocks), dim3(256), args, 0, stream);
  if (e != hipSuccess) fprintf(stderr, "cooperative launch failed: %s (grid %d)\n", hipGetErrorString(e), grid_blocks);
#endif
#else
  phase_kernel<-1><<<512, 256, 0, stream>>>(p, 0);
  for (int l = 0; l < 2; ++l) {
    phase_kernel<0><<<512, 256, 0, stream>>>(p, l);
    phase_kernel<1><<<512, 256, 0, stream>>>(p, l);
    phase_kernel<2><<<512, 256, 0, stream>>>(p, l);
    phase_kernel<3><<<512, 256, 0, stream>>>(p, l);
    phase_kernel<4><<<512, 256, 0, stream>>>(p, l);
    phase_kernel<5><<<512, 256, 0, stream>>>(p, l);
    phase_kernel<6><<<512, 256, 0, stream>>>(p, l);
    phase_kernel<7><<<512, 256, 0, stream>>>(p, l);
    phase_kernel<8><<<512, 256, 0, stream>>>(p, l);
    phase_kernel<9><<<512, 256, 0, stream>>>(p, l);
    phase_kernel<10><<<512, 256, 0, stream>>>(p, l);
    phase_kernel<11><<<512, 256, 0, stream>>>(p, l);
    phase_kernel<12><<<512, 256, 0, stream>>>(p, l);
  }
#endif
}
```
